# Optimizing an MI355X kernel written in HIP

```python
import jax, jax.numpy as jnp
from jax import lax
import numpy as np

D_MODEL = 1024
BATCH = 16
SEQ = 2048
DEPTH = 4
DEC_BATCH = 32
DEC_SEQ = 32
PAST_LEN = 2048

CHUNK = 64
N_HEADS = 16
N_KV_HEADS = 4
HEAD_DIM = 64
GROUP = N_HEADS // N_KV_HEADS
WINDOW = 128
N_BACK_CHUNKS = WINDOW // CHUNK
D_ATTN = N_HEADS * HEAD_DIM
D_KV = N_KV_HEADS * HEAD_DIM
D_LRU = D_MODEL
N_LRU_BLOCKS = 16
LRU_BLOCK = D_LRU // N_LRU_BLOCKS
LRU_C = 8.0
LRU_CONV_W = 4
D_FF = 3 * D_MODEL
FFN_CONV_W = 3
N_BRANCH = 2
D_IN = 2 * D_LRU + D_ATTN + 2 * D_KV + N_BRANCH * D_MODEL
IN_SPLITS = [D_LRU, 2 * D_LRU, 2 * D_LRU + D_ATTN, 2 * D_LRU + D_ATTN + D_KV, 2 * D_LRU + D_ATTN + 2 * D_KV]
EPS = 1e-6
NEG = -1e30

kernel_name = "hawk_swa_sink_convffn_stream"


def rmsnorm(x, g):
    xf = x.astype(jnp.float32)
    y = xf * lax.rsqrt(jnp.mean(xf * xf, axis=-1, keepdims=True) + EPS)
    return (y * g.astype(jnp.float32)).astype(x.dtype)


def causal_dwconv(x, prev, w, b):
    width = w.shape[0]
    T = x.shape[1]
    xe = jnp.concatenate([prev.astype(x.dtype), x], axis=1)
    y = b
    for j in range(width):
        y = y + w[j] * xe[:, j:j + T]
    return y, xe[:, xe.shape[1] - (width - 1):]


def block_diag(x, w, b):
    B, T, _ = x.shape
    xr = x.reshape(B, T, N_LRU_BLOCKS, LRU_BLOCK)
    return jnp.einsum('btnc,ncd->btnd', xr, w).reshape(B, T, D_LRU) + b


def rg_lru(x, h_prev, w_a, b_a, w_i, b_i, lam):
    r = jax.nn.sigmoid(block_diag(x, w_a, b_a).astype(jnp.float32))
    i = jax.nn.sigmoid(block_diag(x, w_i, b_i).astype(jnp.float32))
    log_a = -LRU_C * r * jax.nn.softplus(-lam.astype(jnp.float32))
    a = jnp.exp(log_a)
    mult = jnp.sqrt(-jnp.expm1(2.0 * log_a))
    bterm = mult * i * x.astype(jnp.float32)

    def combine(lhs, rhs):
        a1, b1 = lhs
        a2, b2 = rhs
        return a1 * a2, a2 * b1 + b2

    A, Bc = lax.associative_scan(combine, (a, bterm), axis=1)
    h = A * h_prev.astype(jnp.float32)[:, None] + Bc
    return h.astype(x.dtype), h[:, -1].astype(h_prev.dtype)


def sink_softmax(s, sink):
    col = jnp.broadcast_to(sink, s.shape[:-1] + (1,))
    return jax.nn.softmax(jnp.concatenate([s, col], axis=-1), axis=-1)[..., :-1]


def attn_prompt(q, k, v, sink):
    B, S = q.shape[:2]
    nc = S // CHUNK
    nkb = N_BACK_CHUNKS + 1
    qc = q.reshape(B, nc, CHUNK, N_KV_HEADS, GROUP, HEAD_DIM)
    pad = ((0, 0), (N_BACK_CHUNKS * CHUNK, 0), (0, 0), (0, 0))
    kp = jnp.pad(k, pad).reshape(B, nc + N_BACK_CHUNKS, CHUNK, N_KV_HEADS, HEAD_DIM)
    vp = jnp.pad(v, pad).reshape(B, nc + N_BACK_CHUNKS, CHUNK, N_KV_HEADS, HEAD_DIM)
    kb = jnp.concatenate([kp[:, j:j + nc] for j in range(nkb)], axis=2)
    vb = jnp.concatenate([vp[:, j:j + nc] for j in range(nkb)], axis=2)
    key_chunk = jnp.arange(nc)[:, None] - N_BACK_CHUNKS + jnp.arange(nkb * CHUNK)[None, :] // CHUNK
    valid = key_chunk >= 0
    s = jnp.einsum('bnqkgd,bnskd->bnkgqs', qc.astype(jnp.float32), kb.astype(jnp.float32)) * (HEAD_DIM ** -0.5)
    s = jnp.where(valid[None, :, None, None, None, :], s, NEG)
    p = sink_softmax(s, sink.reshape(N_KV_HEADS, GROUP)[:, :, None, None].astype(jnp.float32))
    o = jnp.einsum('bnkgqs,bnskd->bnqkgd', p.astype(vb.dtype), vb)
    return o.reshape(B, S, D_ATTN)


def attn_sample(q, k, v, sink, k_cache, v_cache):
    B, T = q.shape[:2]
    kk = jnp.concatenate([k_cache.astype(k.dtype), k], axis=1)
    vv = jnp.concatenate([v_cache.astype(v.dtype), v], axis=1)
    qg = q.reshape(B, T, N_KV_HEADS, GROUP, HEAD_DIM)
    s = jnp.einsum('btkgd,bskd->bkgts', qg.astype(jnp.float32), kk.astype(jnp.float32)) * (HEAD_DIM ** -0.5)
    p = sink_softmax(s, sink.reshape(N_KV_HEADS, GROUP)[:, :, None, None].astype(jnp.float32))
    o = jnp.einsum('bkgts,bskd->btkgd', p.astype(vv.dtype), vv)
    return o.reshape(B, T, D_ATTN)


def layer(x, lp, lru_conv_prev, lru_h_prev, ffn_conv_prev, attn_fn):
    (g_mix, w_in, b_gate, w_lconv, b_lconv, w_a, b_a, w_i, b_i, lam, g_q, g_k, sink,
     w_br_lru, w_br_attn, w_out, g_ffn, w_up, w_fconv, b_fconv, w_down) = lp
    B, T, _ = x.shape
    xn = rmsnorm(x, g_mix)
    u_lru, y_lru, q, k, v, gates = jnp.split(xn @ w_in, IN_SPLITS, axis=-1)
    xc, lru_conv_new = causal_dwconv(u_lru, lru_conv_prev, w_lconv, b_lconv)
    h, lru_h_new = rg_lru(xc, lru_h_prev, w_a, b_a, w_i, b_i, lam)
    br_lru = (h * jax.nn.gelu(y_lru)) @ w_br_lru
    q = rmsnorm(q.reshape(B, T, N_HEADS, HEAD_DIM), g_q)
    k = rmsnorm(k.reshape(B, T, N_KV_HEADS, HEAD_DIM), g_k)
    v = v.reshape(B, T, N_KV_HEADS, HEAD_DIM)
    br_attn = attn_fn(q, k, v, sink) @ w_br_attn
    g = jax.nn.sigmoid((gates + b_gate).astype(jnp.float32)).astype(x.dtype).reshape(B, T, N_BRANCH, D_MODEL)
    x = x + (g[:, :, 0] * br_lru + g[:, :, 1] * br_attn) @ w_out
    gate_pre, up = jnp.split(rmsnorm(x, g_ffn) @ w_up, [D_FF], axis=-1)
    gc, ffn_conv_new = causal_dwconv(gate_pre, ffn_conv_prev, w_fconv, b_fconv)
    x = x + (jax.nn.gelu(gc) * up) @ w_down
    return x, k, v, lru_conv_new, lru_h_new, ffn_conv_new


def setup_inputs(seed: int = 0) -> dict:
    key = jax.random.key(seed)
    ks = jax.random.split(key, 32)
    nrm = lambda k, shape, scale: jax.random.normal(k, shape, jnp.float32) * scale
    a8 = jax.random.uniform(ks[13], (DEPTH, D_LRU), jnp.float32, 0.9, 0.999)
    base = a8 ** (1.0 / LRU_C)
    return {
        'x_prompt': nrm(ks[0], (BATCH, SEQ, D_MODEL), 1.0),
        'x_sample': nrm(ks[1], (DEC_BATCH, DEC_SEQ, D_MODEL), 1.0),
        'state_lru_conv': nrm(ks[2], (DEPTH, DEC_BATCH, LRU_CONV_W - 1, D_LRU), 1.0),
        'state_lru_h': nrm(ks[3], (DEPTH, DEC_BATCH, D_LRU), 0.5),
        'cache_k': nrm(ks[4], (DEPTH, DEC_BATCH, min(WINDOW, PAST_LEN), N_KV_HEADS, HEAD_DIM), 1.0),
        'cache_v': nrm(ks[5], (DEPTH, DEC_BATCH, min(WINDOW, PAST_LEN), N_KV_HEADS, HEAD_DIM), 1.0),
        'state_ffn_conv': nrm(ks[6], (DEPTH, DEC_BATCH, FFN_CONV_W - 1, D_FF), 1.0),
        'g_mix': 1.0 + nrm(ks[7], (DEPTH, D_MODEL), 0.02),
        'w_in': nrm(ks[8], (DEPTH, D_MODEL, D_IN), D_MODEL ** -0.5),
        'b_gate': nrm(ks[9], (DEPTH, N_BRANCH * D_MODEL), 0.02),
        'w_lru_conv': nrm(ks[10], (DEPTH, LRU_CONV_W, D_LRU), LRU_CONV_W ** -0.5),
        'b_lru_conv': nrm(ks[11], (DEPTH, D_LRU), 0.02),
        'w_lru_a': nrm(ks[12], (DEPTH, N_LRU_BLOCKS, LRU_BLOCK, LRU_BLOCK), LRU_BLOCK ** -0.5),
        'b_lru_a': nrm(ks[14], (DEPTH, D_LRU), 0.02),
        'w_lru_i': nrm(ks[15], (DEPTH, N_LRU_BLOCKS, LRU_BLOCK, LRU_BLOCK), LRU_BLOCK ** -0.5),
        'b_lru_i': nrm(ks[16], (DEPTH, D_LRU), 0.02),
        'lru_lambda': jnp.log(base) - jnp.log1p(-base),
        'g_q': 1.0 + nrm(ks[17], (DEPTH, HEAD_DIM), 0.02),
        'g_k': 1.0 + nrm(ks[18], (DEPTH, HEAD_DIM), 0.02),
        'attn_sink': nrm(ks[19], (DEPTH, N_HEADS), 0.5),
        'w_br_lru': nrm(ks[20], (DEPTH, D_LRU, D_MODEL), D_LRU ** -0.5),
        'w_br_attn': nrm(ks[21], (DEPTH, D_ATTN, D_MODEL), D_ATTN ** -0.5),
        'w_out': nrm(ks[22], (DEPTH, D_MODEL, D_MODEL), D_MODEL ** -0.5),
        'g_ffn': 1.0 + nrm(ks[23], (DEPTH, D_MODEL), 0.02),
        'w_up': nrm(ks[24], (DEPTH, D_MODEL, 2 * D_FF), D_MODEL ** -0.5),
        'w_ffn_conv': nrm(ks[25], (DEPTH, FFN_CONV_W, D_FF), FFN_CONV_W ** -0.5),
        'b_ffn_conv': nrm(ks[26], (DEPTH, D_FF), 0.02),
        'w_down': nrm(ks[27], (DEPTH, D_FF, D_MODEL), D_FF ** -0.5),
    }


def reference(x_prompt, x_sample, state_lru_conv, state_lru_h, cache_k, cache_v, state_ffn_conv,
              g_mix, w_in, b_gate, w_lru_conv, b_lru_conv, w_lru_a, b_lru_a, w_lru_i, b_lru_i,
              lru_lambda, g_q, g_k, attn_sink, w_br_lru, w_br_attn, w_out, g_ffn, w_up,
              w_ffn_conv, b_ffn_conv, w_down):
    params = (g_mix, w_in, b_gate, w_lru_conv, b_lru_conv, w_lru_a, b_lru_a, w_lru_i, b_lru_i,
              lru_lambda, g_q, g_k, attn_sink, w_br_lru, w_br_attn, w_out, g_ffn, w_up,
              w_ffn_conv, b_ffn_conv, w_down)
    xp, xs = x_prompt, x_sample
    B = xp.shape[0]
    p_lc, p_lh, p_k, p_v, p_fc = [], [], [], [], []
    s_lc, s_lh, s_k, s_v, s_fc = [], [], [], [], []
    for l in range(DEPTH):
        lp = tuple(p[l] for p in params)
        xp, kp, vp, lc, lh, fc = layer(
            xp, lp,
            jnp.zeros((B, LRU_CONV_W - 1, D_LRU), xp.dtype),
            jnp.zeros((B, D_LRU), xp.dtype),
            jnp.zeros((B, FFN_CONV_W - 1, D_FF), xp.dtype),
            attn_prompt)
        p_lc.append(lc); p_lh.append(lh); p_fc.append(fc)
        p_k.append(kp[:, kp.shape[1] - WINDOW:]); p_v.append(vp[:, vp.shape[1] - WINDOW:])
        ck, cv = cache_k[l], cache_v[l]
        xs, ks_, vs_, lc, lh, fc = layer(
            xs, lp, state_lru_conv[l], state_lru_h[l], state_ffn_conv[l],
            lambda q, k, v, s: attn_sample(q, k, v, s, ck, cv))
        s_lc.append(lc); s_lh.append(lh); s_fc.append(fc); s_k.append(ks_); s_v.append(vs_)
    return (xp, xs,
            jnp.stack(p_lc), jnp.stack(p_lh), jnp.stack(p_k), jnp.stack(p_v), jnp.stack(p_fc),
            jnp.stack(s_lc), jnp.stack(s_lh), jnp.stack(s_k), jnp.stack(s_v), jnp.stack(s_fc))
```

```cpp
#include <hip/hip_runtime.h>
#include <hip/hip_cooperative_groups.h>
#include <cstdio>
namespace cg = cooperative_groups;

#ifndef MK_ONE_LAUNCH
#define MK_ONE_LAUNCH 0
#endif

#define LAS __attribute__((address_space(3)))
#define DI __device__ __forceinline__
typedef unsigned short bf16_t;
typedef short bf16x8 __attribute__((ext_vector_type(8)));
typedef float f32x4 __attribute__((ext_vector_type(4)));
typedef float f32x16 __attribute__((ext_vector_type(16)));
typedef float f32x2 __attribute__((ext_vector_type(2)));
typedef __bf16 bf2_t __attribute__((ext_vector_type(2)));
typedef unsigned u32x4 __attribute__((ext_vector_type(4)));
typedef unsigned u32x2 __attribute__((ext_vector_type(2)));

constexpr int T_P = 32768, T_S = 1024, T_ALL = T_P + T_S;
constexpr int DM = 1024, DIN = 5632, DFF = 3072;
constexpr float EPS = 1e-6f;
constexpr float LOG2E = 1.4426950408889634f;

constexpr size_t OUT_PLC = 34603008, OUT_PLH = 34799616, OUT_PK = 34865152, OUT_PV = 36962304, OUT_PFC = 39059456,
                 OUT_SLC = 39452672, OUT_SLH = 39845888, OUT_SK = 39976960, OUT_SV = 41025536, OUT_SFC = 42074112;

constexpr size_t SZ_WIN = (size_t)DIN * DM * 2, SZ_WSQ = (size_t)DM * DM * 2, SZ_WUP = (size_t)2 * DFF * DM * 2, SZ_WDN = (size_t)DM * DFF * 2, SZ_WBD = 16 * 64 * 64 * 2;
constexpr size_t WS_WIN = 0;
constexpr size_t WS_WBR = WS_WIN + 4 * SZ_WIN;
constexpr size_t WS_WOUT = WS_WBR + 8 * SZ_WSQ;
constexpr size_t WS_WUP = WS_WOUT + 4 * SZ_WSQ;
constexpr size_t WS_WDN = WS_WUP + 4 * SZ_WUP;
constexpr size_t WS_WA = WS_WDN + 4 * SZ_WDN;
constexpr size_t WS_WI = WS_WA + 4 * SZ_WBD;
constexpr size_t WS_XB = WS_WI + 4 * SZ_WBD;
constexpr size_t SLOT = (size_t)T_ALL * DM * 2;
constexpr size_t WS_SSQ = WS_XB + SLOT;
constexpr size_t WS_ST = WS_SSQ + (size_t)T_ALL * 16 * 4;
constexpr size_t WS_U = WS_ST, WS_GY = WS_ST + SLOT, WS_Q = WS_ST + 2 * SLOT, WS_GATES = WS_ST + 3 * SLOT, WS_K = WS_ST + 5 * SLOT, WS_V = WS_K + (size_t)T_ALL * 256 * 2;
constexpr size_t WS_MIX = WS_U;
constexpr size_t WS_GP = WS_ST, WS_UP = WS_ST + 3 * SLOT;
constexpr size_t WS_END = WS_ST + 6 * SLOT;

struct Params {
  const float* in[28];
  float* out;
  unsigned char* ws;
  int ph_lo, ph_hi;
};

DI unsigned pk2(float lo, float hi) { f32x2 v = {lo, hi}; bf2_t r = __builtin_convertvector(v, bf2_t); return __builtin_bit_cast(unsigned, r); }
DI float bf2f(unsigned short h) { return __uint_as_float(((unsigned)h) << 16); }
DI float bflo(unsigned w) { return __uint_as_float(w << 16); }
DI float bfhi(unsigned w) { return __uint_as_float(w & 0xffff0000u); }
DI float sigmoidf_(float x) { return __builtin_amdgcn_rcpf(1.0f + __builtin_amdgcn_exp2f(-x * LOG2E)); }
DI float gelu_tanh(float x) {
  const float u = x * (1.0f + 0.044715f * x * x) * (1.5957691216057308f * LOG2E);
  return x * __builtin_amdgcn_rcpf(1.0f + __builtin_amdgcn_exp2f(-u));
}
DI u32x4 pack8(const float* v) { u32x4 w; w.x = pk2(v[0], v[1]); w.y = pk2(v[2], v[3]); w.z = pk2(v[4], v[5]); w.w = pk2(v[6], v[7]); return w; }

namespace pg8 {
constexpr int BM = 256, BK = 64, HALF = 128, HTB = HALF * BK * 2, STAGE_BYTES = 8 * HTB, NXCD = 8, WGM = 8;
DI int lds_byte(int r, int c) { const int st = (r >> 4) * 2 + (c >> 5), rr = r & 15, cc = c & 31, ob = rr * 64 + cc * 2; return st * 1024 + (ob ^ (((ob >> 9) & 1) << 5)); }
DI void stage_rc(int b, int& R, int& C) { const int st = b / 1024, sb = b % 1024, swz = sb ^ (((sb >> 9) & 1) << 5); R = (st >> 1) * 16 + swz / 64; C = (st & 1) * 32 + (swz % 64) / 2; }
DI int perm32(int rho) { const int n = rho >> 4, i = rho & 15; return 8 * (i >> 2) + 4 * n + (i & 3); }

struct Unit { int pm, pn, z; };
struct Gemm { const bf16_t *A0, *A1, *B0, *B1; int K; };

struct Order {
  int nM, nN, nwg, G, c, pair;
  DI void init(int M, int N, int G_, int c_, int pair_) { nM = M / BM; nN = N / BM; nwg = nM * nN; G = G_; c = c_; pair = pair_; }
  DI bool next(int i, Unit& u) const {
    const int ii = pair ? (i >> 1) : i;
    const long L = (long)ii * G + c; if (L >= nwg) return false;
    int wgid = (int)L; { const int q = nwg / NXCD, r = nwg % NXCD, xcd = wgid % NXCD, off = wgid / NXCD; wgid = (xcd < r ? xcd * (q + 1) : r * (q + 1) + (xcd - r) * q) + off; }
    const int nig = WGM * nN, gid = wgid / nig, fm = gid * WGM, gsz = (nM - fm) < WGM ? (nM - fm) : WGM;
    u.pm = fm + ((wgid % nig) % gsz); u.pn = (wgid % nig) / gsz; u.z = pair ? (i & 1) : 0; return true;
  }
};

template <class Epi>
DI void gemm_phase(const int tid, LAS unsigned char* lds, const Gemm g, const Order& S, const Epi& E) {
  const int wid = __builtin_amdgcn_readfirstlane(tid >> 6), lane = tid & 63, wr = wid >> 2, wc = wid & 3, fr = lane & 15, fq = lane >> 4;
  const int K = g.K, nt = K / BK;
  unsigned voffA[2], voffB[2];
#pragma unroll
  for (int i = 0; i < 2; ++i) { int R, C; stage_rc(tid * 16 + i * 8192, R, C); const int Rb = (R & ~31) + perm32(R & 31);
    voffA[i] = (unsigned)(R * K + C) * 2u; voffB[i] = (unsigned)(Rb * K + C) * 2u; }
  const size_t kstep = (size_t)(BK * 2);
  const size_t hstep = (size_t)HALF * K * 2;
  const size_t tstep = 2 * hstep;
  const unsigned ldsw = (unsigned)wid * 1024u;
  const int aoff = lds_byte(wr * 64 + fr, fq * 8), boff = lds_byte(wc * 32 + fr, fq * 8);
#define PG8_SA(b, h) (((b) * 2 + (h)) * HTB)
#define PG8_SB(b, h) ((4 + (b) * 2 + (h)) * HTB)
#define PG8_STAGE(bufoff, gbase, voff) do { _Pragma("unroll") for (int _i = 0; _i < 2; ++_i) \
    __builtin_amdgcn_global_load_lds((const unsigned*)((const char*)(gbase) + (voff)[_i]), (LAS unsigned*)(lds + (bufoff) + ldsw + _i * 8192), 16, 0, 0); } while (0)
#define PG8_LDA(dst, b, h) do { _Pragma("unroll") for (int m = 0; m < 4; ++m) _Pragma("unroll") for (int k = 0; k < 2; ++k) dst[m][k] = *(const LAS bf16x8*)(lds + PG8_SA(b, h) + aoff + m * 2048 + k * 1024); } while (0)
#define PG8_LDB(dst, b, h) do { _Pragma("unroll") for (int n = 0; n < 2; ++n) _Pragma("unroll") for (int k = 0; k < 2; ++k) dst[n][k] = *(const LAS bf16x8*)(lds + PG8_SB(b, h) + boff + n * 2048 + k * 1024); } while (0)
#define PG8_MMA(ai, bj, At, Bt) do { __builtin_amdgcn_s_setprio(1); _Pragma("unroll") for (int m = 0; m < 4; ++m) _Pragma("unroll") for (int n = 0; n < 2; ++n) _Pragma("unroll") for (int k = 0; k < 2; ++k) \
    acc[ai][bj][m][n] = __builtin_amdgcn_mfma_f32_16x16x32_bf16(Bt[n][k], At[m][k], acc[ai][bj][m][n], 0, 0, 0); __builtin_amdgcn_s_setprio(0); } while (0)
#define PG8_WAIT_V(n) asm volatile("s_waitcnt vmcnt(" #n ")" ::: "memory")
#define PG8_WAIT_L(n) asm volatile("s_waitcnt lgkmcnt(" #n ")" ::: "memory")
#define PG8_BAR __builtin_amdgcn_s_barrier()
#define PG8_SCHED __builtin_amdgcn_sched_barrier(0)
  Unit cur, nxt; int ui = 0;
  if (!S.next(0, cur)) return;
  f32x4 acc[2][2][4][2];
#pragma unroll
  for (int a = 0; a < 2; ++a)
#pragma unroll
    for (int b = 0; b < 2; ++b)
#pragma unroll
      for (int m = 0; m < 4; ++m)
#pragma unroll
        for (int n = 0; n < 2; ++n) acc[a][b][m][n] = (f32x4){0.f, 0.f, 0.f, 0.f};
  bf16x8 At[4][2], B0[2][2], B1[2][2];
  const char* cA = (const char*)(cur.z ? g.A1 : g.A0) + (size_t)cur.pm * tstep; const char* cB = (const char*)(cur.z ? g.B1 : g.B0) + (size_t)cur.pn * tstep;
  PG8_STAGE(PG8_SB(0, 0), cB, voffB); PG8_STAGE(PG8_SA(0, 0), cA, voffA); PG8_STAGE(PG8_SB(0, 1), cB + hstep, voffB); PG8_STAGE(PG8_SA(0, 1), cA + hstep, voffA);
  if (wr == 1) PG8_BAR;
  PG8_WAIT_V(4); PG8_BAR;
  PG8_STAGE(PG8_SB(1, 0), cB + kstep, voffB); PG8_STAGE(PG8_SA(1, 0), cA + kstep, voffA); PG8_STAGE(PG8_SB(1, 1), cB + hstep + kstep, voffB);
  PG8_WAIT_V(6); PG8_BAR;
  for (;;) {
    const bool has_next = S.next(ui + 1, nxt);
    const char* nA = has_next ? (const char*)(nxt.z ? g.A1 : g.A0) + (size_t)nxt.pm * tstep : cA; const char* nB = has_next ? (const char*)(nxt.z ? g.B1 : g.B0) + (size_t)nxt.pn * tstep : cB;
    for (int t = 0; t < nt; t += 2) {
      const bool last = (t == nt - 2);
      const char* a1 = cA + (size_t)(t + 1) * kstep;
      const char* a2 = last ? nA : cA + (size_t)(t + 2) * kstep; const char* b2 = last ? nB : cB + (size_t)(t + 2) * kstep;
      const char* a3 = a2 + kstep; const char* b3 = b2 + kstep;
      PG8_LDB(B0, 0, 0); PG8_SCHED; PG8_LDA(At, 0, 0); PG8_STAGE(PG8_SA(1, 1), a1 + hstep, voffA);
      PG8_WAIT_L(8); PG8_BAR; PG8_WAIT_L(0); PG8_MMA(0, 0, At, B0); PG8_BAR; PG8_SCHED;
      PG8_LDB(B1, 0, 1); PG8_STAGE(PG8_SB(0, 0), b2, voffB);
      PG8_BAR; PG8_WAIT_L(0); PG8_MMA(0, 1, At, B1); PG8_BAR;
      PG8_LDA(At, 0, 1); PG8_STAGE(PG8_SA(0, 0), a2, voffA);
      PG8_BAR; PG8_WAIT_L(0); PG8_MMA(1, 0, At, B0); PG8_BAR; PG8_SCHED;
      PG8_STAGE(PG8_SB(0, 1), b2 + hstep, voffB);
      PG8_WAIT_V(6); PG8_BAR; PG8_MMA(1, 1, At, B1); PG8_BAR;
      PG8_LDB(B0, 1, 0); PG8_SCHED; PG8_LDA(At, 1, 0); PG8_STAGE(PG8_SA(0, 1), a2 + hstep, voffA);
      PG8_WAIT_L(8); PG8_BAR; PG8_WAIT_L(0); PG8_MMA(0, 0, At, B0); PG8_BAR; PG8_SCHED;
      PG8_LDB(B1, 1, 1); PG8_STAGE(PG8_SB(1, 0), b3, voffB);
      PG8_BAR; PG8_WAIT_L(0); PG8_MMA(0, 1, At, B1); PG8_BAR;
      PG8_LDA(At, 1, 1); PG8_STAGE(PG8_SA(1, 0), a3, voffA);
      PG8_BAR; PG8_WAIT_L(0); PG8_MMA(1, 0, At, B0); PG8_BAR; PG8_SCHED;
      PG8_STAGE(PG8_SB(1, 1), b3 + hstep, voffB);
      PG8_WAIT_V(6); PG8_BAR; PG8_MMA(1, 1, At, B1); PG8_BAR;
    }
    { int fr2 = fr, fq2 = fq; asm volatile("" : "+v"(fr2), "+v"(fq2)); E(acc, cur, wr, wc, fr2, fq2); }
    if (!has_next) break;
#pragma unroll
    for (int a = 0; a < 2; ++a)
#pragma unroll
      for (int b = 0; b < 2; ++b)
#pragma unroll
        for (int m = 0; m < 4; ++m)
#pragma unroll
          for (int n = 0; n < 2; ++n) acc[a][b][m][n] = (f32x4){0.f, 0.f, 0.f, 0.f};
    cur = nxt; cA = nA; cB = nB; ++ui;
  }
  PG8_WAIT_V(0);
  if (wr == 0) PG8_BAR;
  PG8_BAR;
#undef PG8_SA
#undef PG8_SB
#undef PG8_STAGE
#undef PG8_LDA
#undef PG8_LDB
#undef PG8_MMA
#undef PG8_WAIT_V
#undef PG8_WAIT_L
#undef PG8_BAR
#undef PG8_SCHED
}
}
using pg8::Unit;
typedef f32x4 AccT[2][2][4][2];

DI float row_rs(const float* ssq, int row, int fq) {
  const f32x4 pp = *(const f32x4*)(ssq + (size_t)row * 16 + 4 * fq);
  float s = pp.x + pp.y + pp.z + pp.w; s += __shfl_xor(s, 16); s += __shfl_xor(s, 32);
  return rsqrtf(s * (1.0f / 1024.0f) + EPS);
}

struct Epi1 {
  bf16_t *U, *GY, *Q, *Kb, *Vb, *GATES; const float* ssq; const float *b_gate, *g_q, *g_k; float* out; int l;
  template <int REG> DI void body(const AccT& acc, const Unit& u, int wr, int wc, int fr, int fq) const {
    const int pn = u.pn;
#pragma unroll
    for (int ai = 0; ai < 2; ++ai)
#pragma unroll
      for (int m = 0; m < 4; ++m) {
        const int row = u.pm * 256 + ai * 128 + wr * 64 + m * 16 + fr;
        const float rs = row_rs(ssq, row, fq);
        float v[2][8];
#pragma unroll
        for (int bj = 0; bj < 2; ++bj)
#pragma unroll
          for (int n = 0; n < 2; ++n)
#pragma unroll
            for (int j = 0; j < 4; ++j) v[bj][4 * n + j] = acc[ai][bj][m][n][j] * rs;
        const bool isp = row < T_P; const int rp = row - T_P;
        const int b = isp ? (row >> 11) : (rp >> 5), t = isp ? (row & 2047) : (rp & 31);
        if constexpr (REG == 0) {
          int ooff = -1;
          if (isp) { if (t >= 2045) ooff = (int)OUT_PLC + ((l * 16 + b) * 3 + (t - 2045)) * 1024; }
          else { if (t >= 29) ooff = (int)OUT_SLC + ((l * 32 + b) * 3 + (t - 29)) * 1024; }
#pragma unroll
          for (int bj = 0; bj < 2; ++bj) {
            const int col = pn * 256 + bj * 128 + wc * 32 + fq * 8;
            *(u32x4*)(U + (size_t)row * 1024 + col) = pack8(v[bj]);
            if (ooff >= 0) { float* o = out + ooff + col; *(f32x4*)o = (f32x4){v[bj][0], v[bj][1], v[bj][2], v[bj][3]}; *(f32x4*)(o + 4) = (f32x4){v[bj][4], v[bj][5], v[bj][6], v[bj][7]}; }
          }
        } else if constexpr (REG == 1) {
#pragma unroll
          for (int bj = 0; bj < 2; ++bj) {
            const int col = (pn - 4) * 256 + bj * 128 + wc * 32 + fq * 8;
            float w[8];
#pragma unroll
            for (int i = 0; i < 8; ++i) w[i] = gelu_tanh(v[bj][i]);
            *(u32x4*)(GY + (size_t)row * 1024 + col) = pack8(w);
          }
        } else if constexpr (REG == 2 || REG == 3) {
          float ss = 0.f;
#pragma unroll
          for (int bj = 0; bj < 2; ++bj)
#pragma unroll
            for (int i = 0; i < 8; ++i) ss += v[bj][i] * v[bj][i];
          ss += __shfl_xor(ss, 16); ss += __shfl_xor(ss, 32);
          const float sc = rsqrtf(ss * (1.0f / 64.0f) + EPS);
          const float* gg = (REG == 2 ? g_q : g_k) + l * 64;
          int ooff = -1;
          if (REG == 3) { if (isp) { if (t >= 1920) ooff = (int)OUT_PK + ((l * 16 + b) * 128 + (t - 1920)) * 256; } else ooff = (int)OUT_SK + (l * 1024 + rp) * 256; }
#pragma unroll
          for (int bj = 0; bj < 2; ++bj) {
            const int d0 = 32 * bj + 8 * fq;
            const f32x4 g0 = *(const f32x4*)(gg + d0), g1 = *(const f32x4*)(gg + d0 + 4);
            float w[8];
#pragma unroll
            for (int i = 0; i < 4; ++i) { w[i] = v[bj][i] * sc * g0[i]; w[4 + i] = v[bj][4 + i] * sc * g1[i]; }
            if (REG == 2) *(u32x4*)(Q + (size_t)row * 1024 + (pn - 8) * 256 + 64 * wc + d0) = pack8(w);
            else {
              *(u32x4*)(Kb + (size_t)row * 256 + 64 * wc + d0) = pack8(w);
              if (ooff >= 0) { float* o = out + ooff + 64 * wc + d0; *(f32x4*)o = (f32x4){w[0], w[1], w[2], w[3]}; *(f32x4*)(o + 4) = (f32x4){w[4], w[5], w[6], w[7]}; }
            }
          }
        } else if constexpr (REG == 4) {
          int ooff = -1;
          if (isp) { if (t >= 1920) ooff = (int)OUT_PV + ((l * 16 + b) * 128 + (t - 1920)) * 256; } else ooff = (int)OUT_SV + (l * 1024 + rp) * 256;
#pragma unroll
          for (int bj = 0; bj < 2; ++bj) {
            const int col = bj * 128 + wc * 32 + fq * 8;
            *(u32x4*)(Vb + (size_t)row * 256 + col) = pack8(v[bj]);
            if (ooff >= 0) { float* o = out + ooff + col; *(f32x4*)o = (f32x4){v[bj][0], v[bj][1], v[bj][2], v[bj][3]}; *(f32x4*)(o + 4) = (f32x4){v[bj][4], v[bj][5], v[bj][6], v[bj][7]}; }
          }
        } else {
#pragma unroll
          for (int bj = 0; bj < 2; ++bj) {
            const int col = (pn - 14) * 256 + bj * 128 + wc * 32 + fq * 8;
            const f32x4 b0 = *(const f32x4*)(b_gate + l * 2048 + col), b1 = *(const f32x4*)(b_gate + l * 2048 + col + 4);
            float w[8];
#pragma unroll
            for (int i = 0; i < 4; ++i) { w[i] = sigmoidf_(v[bj][i] + b0[i]); w[4 + i] = sigmoidf_(v[bj][4 + i] + b1[i]); }
            *(u32x4*)(GATES + (size_t)row * 2048 + col) = pack8(w);
          }
        }
        __builtin_amdgcn_sched_barrier(0);
      }
  }
  DI void operator()(const AccT& acc, const Unit& u, int wr, int wc, int fr, int fq) const {
    const int pn = u.pn;
    if (pn < 4) body<0>(acc, u, wr, wc, fr, fq);
    else if (pn < 8) body<1>(acc, u, wr, wc, fr, fq);
    else if (pn < 12) body<2>(acc, u, wr, wc, fr, fq);
    else if (pn == 12) body<3>(acc, u, wr, wc, fr, fq);
    else if (pn == 13) body<4>(acc, u, wr, wc, fr, fq);
    else body<5>(acc, u, wr, wc, fr, fq);
  }
};

struct EpiBr {
  bf16_t* MIX; const bf16_t* GATES;
  DI void operator()(const AccT& acc, const Unit& u, int wr, int wc, int fr, int fq) const {
    const int z = u.z;
#pragma unroll
    for (int ai = 0; ai < 2; ++ai)
#pragma unroll
      for (int m = 0; m < 4; ++m) {
        const int row = u.pm * 256 + ai * 128 + wr * 64 + m * 16 + fr;
#pragma unroll
        for (int bj = 0; bj < 2; ++bj) {
          const int col = u.pn * 256 + bj * 128 + wc * 32 + fq * 8;
          const u32x4 gw = *(const u32x4*)(GATES + (size_t)row * 2048 + z * 1024 + col);
          bf16_t* mp = MIX + (size_t)row * 1024 + col;
          float w[8];
          w[0] = bflo(gw.x) * acc[ai][bj][m][0][0]; w[1] = bfhi(gw.x) * acc[ai][bj][m][0][1]; w[2] = bflo(gw.y) * acc[ai][bj][m][0][2]; w[3] = bfhi(gw.y) * acc[ai][bj][m][0][3];
          w[4] = bflo(gw.z) * acc[ai][bj][m][1][0]; w[5] = bfhi(gw.z) * acc[ai][bj][m][1][1]; w[6] = bflo(gw.w) * acc[ai][bj][m][1][2]; w[7] = bfhi(gw.w) * acc[ai][bj][m][1][3];
          if (z) { const u32x4 pw = *(const u32x4*)mp;
            w[0] += bflo(pw.x); w[1] += bfhi(pw.x); w[2] += bflo(pw.y); w[3] += bfhi(pw.y); w[4] += bflo(pw.z); w[5] += bfhi(pw.z); w[6] += bflo(pw.w); w[7] += bfhi(pw.w); }
          *(u32x4*)mp = pack8(w);
        }
        __builtin_amdgcn_sched_barrier(0);
      }
  }
};

struct EpiRes {
  float* X; bf16_t* XB; float* ssq;
  DI void operator()(const AccT& acc, const Unit& u, int wr, int wc, int fr, int fq) const {
#pragma unroll
    for (int ai = 0; ai < 2; ++ai)
#pragma unroll
      for (int m = 0; m < 4; ++m) {
        const int row = u.pm * 256 + ai * 128 + wr * 64 + m * 16 + fr;
        float ss = 0.f;
#pragma unroll
        for (int bj = 0; bj < 2; ++bj) {
          const int col = u.pn * 256 + bj * 128 + wc * 32 + fq * 8;
          float* xp = X + (size_t)row * 1024 + col;
          const f32x4 x0 = *(const f32x4*)xp, x1 = *(const f32x4*)(xp + 4);
          float w[8];
#pragma unroll
          for (int i = 0; i < 4; ++i) { w[i] = x0[i] + acc[ai][bj][m][0][i]; w[4 + i] = x1[i] + acc[ai][bj][m][1][i]; }
#pragma unroll
          for (int i = 0; i < 8; ++i) ss += w[i] * w[i];
          *(f32x4*)xp = (f32x4){w[0], w[1], w[2], w[3]}; *(f32x4*)(xp + 4) = (f32x4){w[4], w[5], w[6], w[7]};
          *(u32x4*)(XB + (size_t)row * 1024 + col) = pack8(w);
        }
        ss += __shfl_xor(ss, 16); ss += __shfl_xor(ss, 32);
        if (fq == 0) ssq[(size_t)row * 16 + u.pn * 4 + wc] = ss;
        __builtin_amdgcn_sched_barrier(0);
      }
  }
};

struct EpiUp {
  bf16_t *GP, *UP; const float* ssq; float* out; int l;
  DI void operator()(const AccT& acc, const Unit& u, int wr, int wc, int fr, int fq) const {
    const int pn = u.pn; const bool isg = pn < 12;
#pragma unroll
    for (int ai = 0; ai < 2; ++ai)
#pragma unroll
      for (int m = 0; m < 4; ++m) {
        const int row = u.pm * 256 + ai * 128 + wr * 64 + m * 16 + fr;
        const float rs = row_rs(ssq, row, fq);
        const bool isp = row < T_P; const int rp = row - T_P;
        const int b = isp ? (row >> 11) : (rp >> 5), t = isp ? (row & 2047) : (rp & 31);
        int ooff = -1;
        if (isg) { if (isp) { if (t >= 2046) ooff = (int)OUT_PFC + ((l * 16 + b) * 2 + (t - 2046)) * 3072; } else { if (t >= 30) ooff = (int)OUT_SFC + ((l * 32 + b) * 2 + (t - 30)) * 3072; } }
#pragma unroll
        for (int bj = 0; bj < 2; ++bj) {
          const int col = (isg ? pn : pn - 12) * 256 + bj * 128 + wc * 32 + fq * 8;
          float w[8];
#pragma unroll
          for (int i = 0; i < 4; ++i) { w[i] = acc[ai][bj][m][0][i] * rs; w[4 + i] = acc[ai][bj][m][1][i] * rs; }
          *(u32x4*)((isg ? GP : UP) + (size_t)row * 3072 + col) = pack8(w);
          if (ooff >= 0) { float* o = out + ooff + col; *(f32x4*)o = (f32x4){w[0], w[1], w[2], w[3]}; *(f32x4*)(o + 4) = (f32x4){w[4], w[5], w[6], w[7]}; }
        }
        __builtin_amdgcn_sched_barrier(0);
      }
  }
};

DI void tr_tile(const int tid, LAS float* tl, const float* src, int ldsrc, int k0, int n0, const float* gvec, bf16_t* dst, int lddst, int drow0, int hperm) {
  { const int kk = tid >> 3, n8 = (tid & 7) * 8;
    const float* sp = src + (size_t)(k0 + kk) * ldsrc + n0 + n8;
    const f32x4 a = *(const f32x4*)sp, b = *(const f32x4*)(sp + 4);
    const float gsc = gvec ? gvec[k0 + kk] : 1.0f;
    LAS float* tp = tl + kk * 65 + n8;
    tp[0] = a[0] * gsc; tp[1] = a[1] * gsc; tp[2] = a[2] * gsc; tp[3] = a[3] * gsc; tp[4] = b[0] * gsc; tp[5] = b[1] * gsc; tp[6] = b[2] * gsc; tp[7] = b[3] * gsc; }
  __syncthreads();
  { const int nn = tid >> 3, k8 = (tid & 7) * 8;
    float w[8];
#pragma unroll
    for (int i = 0; i < 8; ++i) w[i] = tl[(k8 + i) * 65 + nn];
    const int dr = hperm >= 0 ? (128 * (nn >> 5) + 32 * hperm + (nn & 31)) : nn;
    *(u32x4*)(dst + (size_t)(drow0 + dr) * lddst + k0 + k8) = pack8(w); }
  __syncthreads();
}

DI void phase_prep(const int tid, const int bx, const int G, LAS unsigned char* lds, const Params& p, unsigned char* ws, float* out) {
  LAS float* tl = (LAS float*)lds;
  constexpr int PER_L = 1408 + 256 * 3 + 1536 + 768 + 32;
  for (int tile = bx; tile < 4 * PER_L; tile += G) {
    const int l = tile / PER_L; int r = tile % PER_L;
    if (r < 1408) {
      const int kt = r / 88, ntl = r % 88, n0 = ntl * 64;
      const bool qk = (n0 >= 2048 && n0 < 3328);
      tr_tile(tid, tl, p.in[8] + (size_t)l * DM * DIN, DIN, kt * 64, n0, p.in[7] + l * DM, (bf16_t*)(ws + WS_WIN + l * SZ_WIN), DM, qk ? (n0 & ~255) : n0, qk ? ((n0 & 255) >> 6) : -1);
      continue; }
    r -= 1408;
    if (r < 768) {
      const int which = r >> 8, rr = r & 255, kt = rr >> 4, ntl = rr & 15;
      const float* src = (which == 0 ? p.in[20] : (which == 1 ? p.in[21] : p.in[22])) + (size_t)l * DM * DM;
      bf16_t* dst = which < 2 ? (bf16_t*)(ws + WS_WBR + (size_t)(2 * l + which) * SZ_WSQ) : (bf16_t*)(ws + WS_WOUT + l * SZ_WSQ);
      tr_tile(tid, tl, src, DM, kt * 64, ntl * 64, nullptr, dst, DM, ntl * 64, -1);
      continue; }
    r -= 768;
    if (r < 1536) {
      const int kt = r / 96, ntl = r % 96;
      tr_tile(tid, tl, p.in[24] + (size_t)l * DM * 2 * DFF, 2 * DFF, kt * 64, ntl * 64, p.in[23] + l * DM, (bf16_t*)(ws + WS_WUP + l * SZ_WUP), DM, ntl * 64, -1);
      continue; }
    r -= 1536;
    if (r < 768) {
      const int kt = r >> 4, ntl = r & 15;
      tr_tile(tid, tl, p.in[27] + (size_t)l * DFF * DM, DM, kt * 64, ntl * 64, nullptr, (bf16_t*)(ws + WS_WDN + l * SZ_WDN), DFF, ntl * 64, -1);
      continue; }
    r -= 768;
    {
      const int which = r >> 4, nb = r & 15;
      const float* src = (which ? p.in[14] : p.in[12]) + (size_t)l * 65536 + nb * 4096;
      bf16_t* dst = (bf16_t*)(ws + (which ? WS_WI : WS_WA) + l * SZ_WBD) + nb * 4096;
      tr_tile(tid, tl, src, 64, 0, 0, nullptr, dst, 64, 0, -1);
    }
  }
  const int wave = tid >> 6, lane = tid & 63;
  float* X = out; bf16_t* XB = (bf16_t*)(ws + WS_XB); float* ssq = (float*)(ws + WS_SSQ);
  for (int row = bx * 8 + wave; row < T_ALL; row += G * 8) {
    const float* src = row < T_P ? p.in[0] + (size_t)row * DM : p.in[1] + (size_t)(row - T_P) * DM;
    float ss = 0.f;
#pragma unroll
    for (int i = 0; i < 2; ++i) {
      const int col = i * 512 + lane * 8;
      const f32x4 a = *(const f32x4*)(src + col), b = *(const f32x4*)(src + col + 4);
      *(f32x4*)(X + (size_t)row * DM + col) = a; *(f32x4*)(X + (size_t)row * DM + col + 4) = b;
      float w[8] = {a[0], a[1], a[2], a[3], b[0], b[1], b[2], b[3]};
#pragma unroll
      for (int j = 0; j < 8; ++j) ss += w[j] * w[j];
      *(u32x4*)(XB + (size_t)row * DM + col) = pack8(w);
    }
#pragma unroll
    for (int o = 32; o >= 1; o >>= 1) ss += __shfl_xor(ss, o);
    if (lane < 16) ssq[(size_t)row * 16 + lane] = lane == 0 ? ss : 0.f;
  }
}

DI void lru_item(const int tid, LAS unsigned char* lds, const Params& p, unsigned char* ws, float* out, int l, int seq, int cb) {
  const int wave = tid >> 6, lane = tid & 63;
  LAS float* XCF = (LAS float*)(lds);
  LAS float* AS = (LAS float*)(lds + 32768);
  LAS float* BS = (LAS float*)(lds + 65536);
  LAS bf16_t* XCB = (LAS bf16_t*)(lds + 98304);
  LAS bf16_t* WA = (LAS bf16_t*)(lds + 116736);
  LAS bf16_t* WI = (LAS bf16_t*)(lds + 125952);
  LAS float* SEGA = (LAS float*)(lds + 135168);
  LAS float* SEGB = (LAS float*)(lds + 137216);
  LAS float* HC = (LAS float*)(lds + 139264);
  LAS float* WC = (LAS float*)(lds + 139776);

  const bool isp = seq < 16; const int b = isp ? seq : seq - 16;
  const int row0 = isp ? seq * 2048 : T_P + b * 32;
  const int nchunks = isp ? 16 : 1, nrows = isp ? 128 : 32;
  const bf16_t* U = (const bf16_t*)(ws + WS_U); bf16_t* GY = (bf16_t*)(ws + WS_GY);
  const int c0 = cb * 64;
  __syncthreads();
  { const bf16_t* wa = (const bf16_t*)(ws + WS_WA + l * SZ_WBD) + cb * 4096; const bf16_t* wi = (const bf16_t*)(ws + WS_WI + l * SZ_WBD) + cb * 4096;
    const int n = tid >> 3, k8 = (tid & 7) * 8;
    *(LAS u32x4*)(WA + n * 72 + k8) = *(const u32x4*)(wa + n * 64 + k8);
    *(LAS u32x4*)(WI + n * 72 + k8) = *(const u32x4*)(wi + n * 64 + k8);
    if (tid < 320) { const int j = tid >> 6, c = tid & 63; WC[tid] = j < 4 ? p.in[10][(size_t)(l * 4 + j) * 1024 + c0 + c] : p.in[11][l * 1024 + c0 + c]; }
    if (tid < 64) HC[tid] = isp ? 0.f : p.in[3][(size_t)(l * 32 + b) * 1024 + c0 + tid]; }
  float ba[4], bi[4], sp[4];
#pragma unroll
  for (int nt = 0; nt < 4; ++nt) { const int col = l * 1024 + c0 + 16 * nt + (lane & 15);
    ba[nt] = p.in[13][col]; bi[nt] = p.in[15][col]; sp[nt] = -8.0f * log1pf(expf(-p.in[16][col])); }
  __syncthreads();

  for (int ch = 0; ch < nchunks; ++ch) {
    const int t0 = ch * 128;
    const int sc = tid & 63, seg = tid >> 6;
#pragma unroll 1
    for (int pass = 0; pass < 2; ++pass) {
      const int row = pass * 64 + (tid >> 3), cg = (tid & 7) * 8;
      if (row < nrows) {
        float xc[8];
#pragma unroll
        for (int i = 0; i < 8; ++i) xc[i] = WC[256 + cg + i];
#pragma unroll
        for (int j = 0; j < 4; ++j) {
          const int tt = t0 + row - 3 + j;
          float xe[8];
          if (tt >= 0) {
            const u32x4 a = *(const u32x4*)(U + (size_t)(row0 + tt) * 1024 + c0 + cg);
            xe[0] = bflo(a.x); xe[1] = bfhi(a.x); xe[2] = bflo(a.y); xe[3] = bfhi(a.y); xe[4] = bflo(a.z); xe[5] = bfhi(a.z); xe[6] = bflo(a.w); xe[7] = bfhi(a.w);
          } else if (!isp) {
            const float* sp_ = p.in[2] + ((size_t)(l * 32 + b) * 3 + (tt + 3)) * 1024 + c0 + cg;
#pragma unroll
            for (int i = 0; i < 8; ++i) xe[i] = sp_[i];
          } else {
#pragma unroll
            for (int i = 0; i < 8; ++i) xe[i] = 0.f;
          }
#pragma unroll
          for (int i = 0; i < 8; ++i) xc[i] += WC[j * 64 + cg + i] * xe[i];
        }
        *(LAS f32x4*)(XCF + row * 64 + cg) = (f32x4){xc[0], xc[1], xc[2], xc[3]}; *(LAS f32x4*)(XCF + row * 64 + cg + 4) = (f32x4){xc[4], xc[5], xc[6], xc[7]};
        *(LAS u32x4*)(XCB + row * 72 + cg) = pack8(xc);
      }
    }
    __syncthreads();
    if (wave * 16 < nrows) {
      const int ar = wave * 16 + (lane & 15), kq = 8 * (lane >> 4);
      bf16x8 af[2];
#pragma unroll
      for (int ks = 0; ks < 2; ++ks) af[ks] = *(const LAS bf16x8*)(XCB + ar * 72 + 32 * ks + kq);
#pragma unroll
      for (int nt = 0; nt < 4; ++nt) {
        f32x4 accr = {0.f, 0.f, 0.f, 0.f}, acci = {0.f, 0.f, 0.f, 0.f};
#pragma unroll
        for (int ks = 0; ks < 2; ++ks) {
          const bf16x8 bA = *(const LAS bf16x8*)(WA + (16 * nt + (lane & 15)) * 72 + 32 * ks + kq);
          const bf16x8 bI = *(const LAS bf16x8*)(WI + (16 * nt + (lane & 15)) * 72 + 32 * ks + kq);
          accr = __builtin_amdgcn_mfma_f32_16x16x32_bf16(af[ks], bA, accr, 0, 0, 0);
          acci = __builtin_amdgcn_mfma_f32_16x16x32_bf16(af[ks], bI, acci, 0, 0, 0);
        }
#pragma unroll
        for (int j = 0; j < 4; ++j) {
          const int row = wave * 16 + 4 * (lane >> 4) + j, col = 16 * nt + (lane & 15);
          const float r = sigmoidf_(accr[j] + ba[nt]), ig = sigmoidf_(acci[j] + bi[nt]);
          const float la = sp[nt] * r;
          const float a = __builtin_amdgcn_exp2f(la * LOG2E);
          const float x2 = 2.0f * la;
          const float ser = -x2 * (1.0f + x2 * (0.5f + x2 * (0.16666667f + x2 * (0.041666668f + x2 * (0.008333334f + x2 * 0.0013888889f)))));
          const float om = x2 > -0.25f ? ser : 1.0f - a * a;
          AS[row * 64 + col] = a; BS[row * 64 + col] = sqrtf(om) * ig * XCF[row * 64 + col];
        }
        __builtin_amdgcn_sched_barrier(0);
      }
    }
    __syncthreads();
    const bool act = seg * 16 < nrows;
    unsigned gyv[8];
#pragma unroll
    for (int i = 0; i < 8; ++i) gyv[i] = 0u;
    if (act) {
#pragma unroll
      for (int i = 0; i < 8; ++i) gyv[i] = (unsigned)GY[(size_t)(row0 + t0 + seg * 16 + 2 * i) * 1024 + c0 + sc] | ((unsigned)GY[(size_t)(row0 + t0 + seg * 16 + 2 * i + 1) * 1024 + c0 + sc] << 16);
      float A = 1.f, B = 0.f;
#pragma unroll
      for (int i = 0; i < 16; ++i) { const float a = AS[(seg * 16 + i) * 64 + sc], bb = BS[(seg * 16 + i) * 64 + sc]; B = a * B + bb; A *= a; }
      SEGA[seg * 64 + sc] = A; SEGB[seg * 64 + sc] = B;
    }
    __syncthreads();
    if (act) {
      float h = HC[(ch & 1) * 64 + sc];
      for (int s2 = 0; s2 < seg; ++s2) h = SEGA[s2 * 64 + sc] * h + SEGB[s2 * 64 + sc];
#pragma unroll
      for (int i = 0; i < 16; ++i) {
        const int r = seg * 16 + i;
        h = AS[r * 64 + sc] * h + BS[r * 64 + sc];
        GY[(size_t)(row0 + t0 + r) * 1024 + c0 + sc] = (bf16_t)(pk2(h * ((i & 1) ? bfhi(gyv[i >> 1]) : bflo(gyv[i >> 1])), 0.f) & 0xffffu);
      }
      if ((seg + 1) * 16 == nrows) {
        HC[((ch + 1) & 1) * 64 + sc] = h;
        if (ch == nchunks - 1) out[(isp ? OUT_PLH + (size_t)(l * 16 + b) * 1024 : OUT_SLH + (size_t)(l * 32 + b) * 1024) + c0 + sc] = h;
      }
    }
    __syncthreads();
  }
}

DI void attn_item(const int tid, LAS unsigned char* lds, const Params& p, unsigned char* ws, float* out, int l, int id) {
  const int wave = tid >> 6, lane = tid & 63, r = lane & 31, h = lane >> 5;
  LAS bf16_t* KS = (LAS bf16_t*)lds;
  LAS bf16_t* VT = (LAS bf16_t*)(lds + 27648);
  const bf16_t* Kb = (const bf16_t*)(ws + WS_K); const bf16_t* Vb = (const bf16_t*)(ws + WS_V); bf16_t* Q = (bf16_t*)(ws + WS_Q);
  const bool isp = id < 2048;
  int b, chunk = 0, kvh;
  if (isp) { b = id >> 7; chunk = (id >> 2) & 31; kvh = id & 3; } else { b = (id - 2048) >> 2; kvh = id & 3; }
  __syncthreads();
  for (int pc = tid; pc < 192 * 8; pc += 512) {
    const int kk = pc >> 3, d0 = (pc & 7) * 8;
    u32x4 kw = {0u, 0u, 0u, 0u}, vw = {0u, 0u, 0u, 0u};
    if (isp) {
      const int t = (chunk - 2) * 64 + kk;
      if (t >= 0) { const size_t ro = (size_t)(b * 2048 + t) * 256 + kvh * 64 + d0; kw = *(const u32x4*)(Kb + ro); vw = *(const u32x4*)(Vb + ro); }
    } else if (kk < 128) {
      const size_t co = (((size_t)(l * 32 + b) * 128 + kk) * 4 + kvh) * 64 + d0;
      const f32x4 k0 = *(const f32x4*)(p.in[4] + co), k1 = *(const f32x4*)(p.in[4] + co + 4), v0 = *(const f32x4*)(p.in[5] + co), v1 = *(const f32x4*)(p.in[5] + co + 4);
      kw = (u32x4){pk2(k0[0], k0[1]), pk2(k0[2], k0[3]), pk2(k1[0], k1[1]), pk2(k1[2], k1[3])};
      vw = (u32x4){pk2(v0[0], v0[1]), pk2(v0[2], v0[3]), pk2(v1[0], v1[1]), pk2(v1[2], v1[3])};
    } else if (kk < 160) {
      const size_t ro = (size_t)(T_P + b * 32 + (kk - 128)) * 256 + kvh * 64 + d0; kw = *(const u32x4*)(Kb + ro); vw = *(const u32x4*)(Vb + ro);
    }
    *(LAS u32x4*)(KS + kk * 72 + d0) = kw;
    VT[(d0 + 0) * 200 + kk] = (bf16_t)(vw.x & 0xffffu); VT[(d0 + 1) * 200 + kk] = (bf16_t)(vw.x >> 16);
    VT[(d0 + 2) * 200 + kk] = (bf16_t)(vw.y & 0xffffu); VT[(d0 + 3) * 200 + kk] = (bf16_t)(vw.y >> 16);
    VT[(d0 + 4) * 200 + kk] = (bf16_t)(vw.z & 0xffffu); VT[(d0 + 5) * 200 + kk] = (bf16_t)(vw.z >> 16);
    VT[(d0 + 6) * 200 + kk] = (bf16_t)(vw.w & 0xffffu); VT[(d0 + 7) * 200 + kk] = (bf16_t)(vw.w >> 16);
  }
  __syncthreads();
  const bool active = isp || wave < 4;
  if (active) {
    const int g = isp ? (wave >> 1) : wave, head = kvh * 4 + g;
    const int qrow = isp ? (b * 2048 + chunk * 64 + (wave & 1) * 32 + r) : (T_P + b * 32 + r);
    const int kb_lo = isp ? (chunk >= 2 ? 0 : 2 * (2 - chunk)) : 0, kb_hi = isp ? 6 : 5;
    bf16_t* qp = Q + (size_t)qrow * 1024 + head * 64;
    bf16x8 qf[4];
#pragma unroll
    for (int s = 0; s < 4; ++s) qf[s] = *(const bf16x8*)(qp + 16 * s + 8 * h);
    f32x16 st[6];
#pragma unroll
    for (int kb = 0; kb < 6; ++kb) {
#pragma unroll
      for (int i = 0; i < 16; ++i) st[kb][i] = 0.f;
#pragma unroll
      for (int s = 0; s < 4; ++s) {
        const bf16x8 kf = *(const LAS bf16x8*)(KS + (32 * kb + r) * 72 + 16 * s + 8 * h);
        st[kb] = __builtin_amdgcn_mfma_f32_32x32x16_bf16(kf, qf[s], st[kb], 0, 0, 0);
      }
    }
    const float sinkv = p.in[19][l * 16 + head] * LOG2E;
    const float sscale = 0.125f * LOG2E;
    float mx = sinkv;
#pragma unroll
    for (int kb = 0; kb < 6; ++kb) { const bool valid = kb >= kb_lo && kb < kb_hi;
#pragma unroll
      for (int i = 0; i < 16; ++i) { const float tv = valid ? st[kb][i] * sscale : -1e30f; st[kb][i] = tv; mx = fmaxf(mx, tv); } }
    mx = fmaxf(mx, __shfl_xor(mx, 32));
    float sum = 0.f;
#pragma unroll
    for (int kb = 0; kb < 6; ++kb)
#pragma unroll
      for (int i = 0; i < 16; ++i) { const float pv = __builtin_amdgcn_exp2f(st[kb][i] - mx); st[kb][i] = pv; sum += pv; }
    sum += __shfl_xor(sum, 32);
    sum += __builtin_amdgcn_exp2f(sinkv - mx);
    const float inv = 1.0f / sum;
    f32x16 ot[2];
#pragma unroll
    for (int db = 0; db < 2; ++db)
#pragma unroll
      for (int i = 0; i < 16; ++i) ot[db][i] = 0.f;
#pragma unroll
    for (int kb = 0; kb < 6; ++kb)
#pragma unroll
      for (int s = 0; s < 2; ++s) {
        u32x4 pw; pw.x = pk2(st[kb][8 * s + 0], st[kb][8 * s + 1]); pw.y = pk2(st[kb][8 * s + 2], st[kb][8 * s + 3]); pw.z = pk2(st[kb][8 * s + 4], st[kb][8 * s + 5]); pw.w = pk2(st[kb][8 * s + 6], st[kb][8 * s + 7]);
        const bf16x8 pf = __builtin_bit_cast(bf16x8, pw);
#pragma unroll
        for (int db = 0; db < 2; ++db) {
          const LAS bf16_t* vp = VT + (32 * db + r) * 200 + 32 * kb + 16 * s + 4 * h;
          const u32x2 lo = *(const LAS u32x2*)vp, hi = *(const LAS u32x2*)(vp + 8);
          const u32x4 vv = {lo.x, lo.y, hi.x, hi.y};
          ot[db] = __builtin_amdgcn_mfma_f32_32x32x16_bf16(__builtin_bit_cast(bf16x8, vv), pf, ot[db], 0, 0, 0);
        }
      }
#pragma unroll
    for (int db = 0; db < 2; ++db)
#pragma unroll
      for (int gg = 0; gg < 4; ++gg) {
        u32x2 w; w.x = pk2(ot[db][4 * gg + 0] * inv, ot[db][4 * gg + 1] * inv); w.y = pk2(ot[db][4 * gg + 2] * inv, ot[db][4 * gg + 3] * inv);
        *(u32x2*)(qp + 32 * db + 8 * gg + 4 * h) = w;
      }
  }
}

DI void phase_mixers(const int tid, const int bx, const int G, LAS unsigned char* lds, const Params& p, unsigned char* ws, float* out, int l) {
  for (int it = bx; it < 768; it += G) lru_item(tid, lds, p, ws, out, l, it >> 4, it & 15);
  for (int it = bx; it < 2176; it += G) attn_item(tid, lds, p, ws, out, l, it);
  __syncthreads();
}

DI void phase_ffnconv(const int tid, const int bx, const int G, const Params& p, unsigned char* ws, int l) {
  const bf16_t* GP = (const bf16_t*)(ws + WS_GP); bf16_t* UP = (bf16_t*)(ws + WS_UP);
  const long nitems = (long)(T_ALL / 32) * 384;
  for (long it = (long)bx * 512 + tid; it < nitems; it += (long)G * 512) {
    const int run = (int)(it / 384), c8 = (int)(it % 384) * 8;
    const int row0 = run * 32;
    const bool isp = row0 < T_P; const int rp = row0 - T_P;
    const bool seqstart = isp ? ((row0 & 2047) == 0) : true;
    float w0[8], w1[8], w2[8], bb[8];
#pragma unroll
    for (int i = 0; i < 8; ++i) { w0[i] = p.in[25][(size_t)(l * 3 + 0) * 3072 + c8 + i]; w1[i] = p.in[25][(size_t)(l * 3 + 1) * 3072 + c8 + i]; w2[i] = p.in[25][(size_t)(l * 3 + 2) * 3072 + c8 + i]; bb[i] = p.in[26][l * 3072 + c8 + i]; }
    float g2[8], g1[8];
    if (!seqstart) {
      const u32x4 a = *(const u32x4*)(GP + (size_t)(row0 - 2) * 3072 + c8), c = *(const u32x4*)(GP + (size_t)(row0 - 1) * 3072 + c8);
      g2[0] = bflo(a.x); g2[1] = bfhi(a.x); g2[2] = bflo(a.y); g2[3] = bfhi(a.y); g2[4] = bflo(a.z); g2[5] = bfhi(a.z); g2[6] = bflo(a.w); g2[7] = bfhi(a.w);
      g1[0] = bflo(c.x); g1[1] = bfhi(c.x); g1[2] = bflo(c.y); g1[3] = bfhi(c.y); g1[4] = bflo(c.z); g1[5] = bfhi(c.z); g1[6] = bflo(c.w); g1[7] = bfhi(c.w);
    } else if (!isp) {
      const float* s = p.in[6] + ((size_t)(l * 32 + (rp >> 5)) * 2) * 3072 + c8;
#pragma unroll
      for (int i = 0; i < 8; ++i) { g2[i] = s[i]; g1[i] = s[3072 + i]; }
    } else {
#pragma unroll
      for (int i = 0; i < 8; ++i) { g2[i] = 0.f; g1[i] = 0.f; }
    }
    for (int rr = 0; rr < 32; ++rr) {
      const size_t off = (size_t)(row0 + rr) * 3072 + c8;
      const u32x4 a = *(const u32x4*)(GP + off), uu = *(const u32x4*)(UP + off);
      float g0[8] = {bflo(a.x), bfhi(a.x), bflo(a.y), bfhi(a.y), bflo(a.z), bfhi(a.z), bflo(a.w), bfhi(a.w)};
      float uv[8] = {bflo(uu.x), bfhi(uu.x), bflo(uu.y), bfhi(uu.y), bflo(uu.z), bfhi(uu.z), bflo(uu.w), bfhi(uu.w)};
      float o[8];
#pragma unroll
      for (int i = 0; i < 8; ++i) { const float gc = bb[i] + w0[i] * g2[i] + w1[i] * g1[i] + w2[i] * g0[i]; o[i] = gelu_tanh(gc) * uv[i]; g2[i] = g1[i]; g1[i] = g0[i]; }
      *(u32x4*)(UP + off) = pack8(o);
    }
  }
}

constexpr int N_PHASES = 1 + 7 * 4;
constexpr int LDS_BYTES = 147456;

__global__ void __launch_bounds__(512, 2) mk_fwd(Params p0) {
  extern __shared__ __attribute__((aligned(16))) unsigned char lds_raw[];
  LAS unsigned char* lds = (LAS unsigned char*)lds_raw;
  cg::grid_group grid = cg::this_grid();
  const int wave_s = __builtin_amdgcn_readfirstlane((int)threadIdx.x >> 6);
  for (int ph = p0.ph_lo; ph < p0.ph_hi; ++ph) {
    const Params& p = p0;
    int lane_; asm volatile("v_mbcnt_lo_u32_b32 %0, -1, 0\n\tv_mbcnt_hi_u32_b32 %0, -1, %0" : "=v"(lane_));
    int tid = wave_s * 64 + lane_, bx = blockIdx.x, G = gridDim.x;
    unsigned char* ws = p0.ws; float* out = p0.out; asm volatile("" : "+v"(tid), "+s"(bx), "+s"(G));
    float* ssq = (float*)(ws + WS_SSQ); bf16_t* XB = (bf16_t*)(ws + WS_XB);
    if (ph == 0) phase_prep(tid, bx, G, lds, p, ws, out);
    else {
      const int l = (ph - 1) / 7, s = (ph - 1) % 7;
      if (s == 0) {
        pg8::Gemm g{XB, XB, (const bf16_t*)(ws + WS_WIN + l * SZ_WIN), (const bf16_t*)(ws + WS_WIN + l * SZ_WIN), DM};
        pg8::Order S; S.init(T_ALL, DIN, G, bx, 0);
        Epi1 E{(bf16_t*)(ws + WS_U), (bf16_t*)(ws + WS_GY), (bf16_t*)(ws + WS_Q), (bf16_t*)(ws + WS_K), (bf16_t*)(ws + WS_V), (bf16_t*)(ws + WS_GATES), ssq, p.in[9], p.in[17], p.in[18], out, l};
        pg8::gemm_phase<Epi1>(tid, lds, g, S, E);
      } else if (s == 1) {
        phase_mixers(tid, bx, G, lds, p, ws, out, l);
      } else if (s == 2) {
        pg8::Gemm g{(const bf16_t*)(ws + WS_GY), (const bf16_t*)(ws + WS_Q), (const bf16_t*)(ws + WS_WBR + (size_t)(2 * l) * SZ_WSQ), (const bf16_t*)(ws + WS_WBR + (size_t)(2 * l + 1) * SZ_WSQ), DM};
        pg8::Order S; S.init(T_ALL, DM, G, bx, 1);
        EpiBr E{(bf16_t*)(ws + WS_MIX), (const bf16_t*)(ws + WS_GATES)};
        pg8::gemm_phase<EpiBr>(tid, lds, g, S, E);
      } else if (s == 3 || s == 6) {
        const bf16_t* A = s == 3 ? (const bf16_t*)(ws + WS_MIX) : (const bf16_t*)(ws + WS_UP);
        const bf16_t* B = s == 3 ? (const bf16_t*)(ws + WS_WOUT + l * SZ_WSQ) : (const bf16_t*)(ws + WS_WDN + l * SZ_WDN);
        pg8::Gemm g{A, A, B, B, s == 3 ? DM : DFF};
        pg8::Order S; S.init(T_ALL, DM, G, bx, 0);
        EpiRes E{out, XB, ssq};
        pg8::gemm_phase<EpiRes>(tid, lds, g, S, E);
      } else if (s == 4) {
        pg8::Gemm g{XB, XB, (const bf16_t*)(ws + WS_WUP + l * SZ_WUP), (const bf16_t*)(ws + WS_WUP + l * SZ_WUP), DM};
        pg8::Order S; S.init(T_ALL, 2 * DFF, G, bx, 0);
        EpiUp E{(bf16_t*)(ws + WS_GP), (bf16_t*)(ws + WS_UP), ssq, out, l};
        pg8::gemm_phase<EpiUp>(tid, lds, g, S, E);
      } else {
        phase_ffnconv(tid, bx, G, p, ws, l);
      }
    }
    if (ph + 1 < p0.ph_hi) grid.sync();
  }
}

extern "C" void kernel_launch(void* const* d_in, const int* in_sizes, int n_in, void* d_out, int out_size, void* d_ws, size_t ws_size, hipStream_t stream) {
  static int grid = 0;
  if (grid == 0) {
    if (n_in != 28 || ws_size < WS_END) { fprintf(stderr, "kernel_launch: need 28 inputs and %zu bytes of workspace, got %d / %zu\n", (size_t)WS_END, n_in, ws_size); grid = -1; return; }
    int dev = 0, cus = 0, per_cu = 0;
    hipGetDevice(&dev); hipDeviceGetAttribute(&cus, hipDeviceAttributeMultiprocessorCount, dev);
    if (hipFuncSetAttribute((const void*)mk_fwd, hipFuncAttributeMaxDynamicSharedMemorySize, LDS_BYTES) != hipSuccess) { fprintf(stderr, "kernel_launch: hipFuncSetAttribute failed\n"); grid = -1; return; }
    hipOccupancyMaxActiveBlocksPerMultiprocessor(&per_cu, (const void*)mk_fwd, 512, LDS_BYTES);
    (void)hipGetLastError();
    if (per_cu < 1) per_cu = 1;
    grid = cus * per_cu;
    if (grid > 256) grid = 256;
  }
  if (grid < 0) return;
  Params p{};
  for (int i = 0; i < 28; ++i) p.in[i] = (const float*)d_in[i];
  p.out = (float*)d_out; p.ws = (unsigned char*)d_ws;
#if MK_ONE_LAUNCH
  p.ph_lo = 0; p.ph_hi = N_PHASES;
  void* args[] = {&p};
  hipError_t e = hipLaunchCooperativeKernel((const void*)mk_fwd, dim3(grid), dim3(512), args, LDS_BYTES, stream);
  if (e != hipSuccess) fprintf(stderr, "cooperative launch failed: %s (grid %d)\n", hipGetErrorString(e), grid);
#else
  for (int ph = 0; ph < N_PHASES; ++ph) {
    p.ph_lo = ph; p.ph_hi = ph + 1;
    hipLaunchKernelGGL(mk_fwd, dim3(grid), dim3(512), LDS_BYTES, stream, p);
  }
#endif
}
```

```cpp
#include <hip/hip_runtime.h>
#include <hip/hip_cooperative_groups.h>
#include <cstdio>
namespace cg = cooperative_groups;

#ifndef MK_ONE_LAUNCH
#define MK_ONE_LAUNCH 1
#endif

#ifndef STAGGER
#define STAGGER 0
#endif
#ifndef PG8_SP2
#define PG8_SP2 1
#endif
#ifndef REP_MASK
#define REP_MASK 0
#endif

#define LAS __attribute__((address_space(3)))
#define DI __device__ __forceinline__
typedef unsigned short bf16_t;
typedef short bf16x8 __attribute__((ext_vector_type(8)));
typedef float f32x4 __attribute__((ext_vector_type(4)));
typedef float f32x16 __attribute__((ext_vector_type(16)));
typedef float f32x2 __attribute__((ext_vector_type(2)));
typedef __bf16 bf2_t __attribute__((ext_vector_type(2)));
typedef unsigned u32x4 __attribute__((ext_vector_type(4)));
typedef unsigned u32x2 __attribute__((ext_vector_type(2)));

constexpr int T_P = 32768, T_S = 1024, T_ALL = T_P + T_S;
constexpr int DM = 1024, DIN = 5632, DFF = 3072;
constexpr float EPS = 1e-6f;
constexpr float LOG2E = 1.4426950408889634f;

constexpr size_t OUT_PLC = 34603008, OUT_PLH = 34799616, OUT_PK = 34865152, OUT_PV = 36962304, OUT_PFC = 39059456,
                 OUT_SLC = 39452672, OUT_SLH = 39845888, OUT_SK = 39976960, OUT_SV = 41025536, OUT_SFC = 42074112;

constexpr size_t SZ_WIN = (size_t)DIN * DM * 2, SZ_WSQ = (size_t)DM * DM * 2, SZ_WUP = (size_t)2 * DFF * DM * 2, SZ_WDN = (size_t)DM * DFF * 2, SZ_WBD = 16 * 64 * 64 * 2;
constexpr size_t WS_WIN = 0;
constexpr size_t WS_WBR = WS_WIN + 4 * SZ_WIN;
constexpr size_t WS_WOUT = WS_WBR + 8 * SZ_WSQ;
constexpr size_t WS_WUP = WS_WOUT + 4 * SZ_WSQ;
constexpr size_t WS_WDN = WS_WUP + 4 * SZ_WUP;
constexpr size_t WS_WA = WS_WDN + 4 * SZ_WDN;
constexpr size_t WS_WI = WS_WA + 4 * SZ_WBD;
constexpr size_t WS_XB = WS_WI + 4 * SZ_WBD;
constexpr size_t SLOT = (size_t)T_ALL * DM * 2;
constexpr size_t WS_SSQ = WS_XB + SLOT;
constexpr size_t WS_ST = WS_SSQ + (size_t)T_ALL * 16 * 4;
constexpr size_t WS_U = WS_ST, WS_GY = WS_ST + SLOT, WS_Q = WS_ST + 2 * SLOT, WS_GATES = WS_ST + 3 * SLOT, WS_K = WS_ST + 5 * SLOT, WS_V = WS_K + (size_t)T_ALL * 256 * 2;
constexpr size_t WS_MIX = WS_U;
constexpr size_t WS_GP = WS_ST, WS_UP = WS_ST + 3 * SLOT;
constexpr size_t WS_H = WS_ST, WS_G0 = WS_ST + (16u << 20), WS_U0 = WS_ST + (48u << 20);
constexpr size_t WS_BAR = WS_ST + 6 * SLOT;
constexpr size_t WS_END = WS_BAR + 16384;

struct Params {
  const float* in[28];
  float* out;
  unsigned char* ws;
  int ph_lo, ph_hi;
};

DI unsigned pk2(float lo, float hi) { f32x2 v = {lo, hi}; bf2_t r = __builtin_convertvector(v, bf2_t); return __builtin_bit_cast(unsigned, r); }
DI float bf2f(unsigned short h) { return __uint_as_float(((unsigned)h) << 16); }
DI float bflo(unsigned w) { return __uint_as_float(w << 16); }
DI float bfhi(unsigned w) { return __uint_as_float(w & 0xffff0000u); }
DI float sigmoidf_(float x) { return __builtin_amdgcn_rcpf(1.0f + __builtin_amdgcn_exp2f(-x * LOG2E)); }
DI float gelu_tanh(float x) {
  const float u = x * (1.0f + 0.044715f * x * x) * (1.5957691216057308f * LOG2E);
  return x * __builtin_amdgcn_rcpf(1.0f + __builtin_amdgcn_exp2f(-u));
}
DI u32x4 pack8(const float* v) { u32x4 w; w.x = pk2(v[0], v[1]); w.y = pk2(v[2], v[3]); w.z = pk2(v[4], v[5]); w.w = pk2(v[6], v[7]); return w; }

namespace pg8 {
constexpr int BM = 256, BK = 64, HALF = 128, HTB = HALF * BK * 2, STAGE_BYTES = 8 * HTB, NXCD = 8, WGM = 8;
DI int lds_byte(int r, int c) { const int st = (r >> 4) * 2 + (c >> 5), rr = r & 15, cc = c & 31, ob = rr * 64 + cc * 2; return st * 1024 + (ob ^ (((ob >> 9) & 1) << 5)); }
DI void stage_rc(int b, int& R, int& C) { const int st = b / 1024, sb = b % 1024, swz = sb ^ (((sb >> 9) & 1) << 5); R = (st >> 1) * 16 + swz / 64; C = (st & 1) * 32 + (swz % 64) / 2; }
DI int perm32(int rho) { const int n = rho >> 4, i = rho & 15; return 8 * (i >> 2) + 4 * n + (i & 3); }

struct Unit { int pm, pn, z; };
struct Gemm { const bf16_t *A0, *A1, *B0, *B1; int K; };

struct Order {
  int nM, nN, nwg, G, c, pair;
  DI void init(int M, int N, int G_, int c_, int pair_) { nM = M / BM; nN = N / BM; nwg = nM * nN; G = G_; c = c_; pair = pair_; }
  DI bool next(int i, Unit& u) const {
    const int ii = pair ? (i >> 1) : i;
    const long L = (long)ii * G + c; if (L >= nwg) return false;
    int wgid = (int)L; { const int q = nwg / NXCD, r = nwg % NXCD, xcd = wgid % NXCD, off = wgid / NXCD; wgid = (xcd < r ? xcd * (q + 1) : r * (q + 1) + (xcd - r) * q) + off; }
    const int nig = WGM * nN, gid = wgid / nig, fm = gid * WGM, gsz = (nM - fm) < WGM ? (nM - fm) : WGM;
    u.pm = fm + ((wgid % nig) % gsz); u.pn = (wgid % nig) / gsz; u.z = pair ? (i & 1) : 0; return true;
  }
};

template <class Epi>
DI void gemm_phase(const int tid_in, LAS unsigned char* lds, const Gemm g, const Order& S, const Epi& E) {
  int tid = tid_in; asm volatile("" : "+v"(tid));
  const int wid = __builtin_amdgcn_readfirstlane(tid >> 6), lane = tid & 63, wr = wid >> 2, wc = wid & 3, fr = lane & 15, fq = lane >> 4;
  const int K = g.K, nt = K / BK;
  unsigned voffA[2], voffB[2];
#pragma unroll
  for (int i = 0; i < 2; ++i) { int R, C; stage_rc(tid * 16 + i * 8192, R, C); const int Rb = (R & ~31) + perm32(R & 31);
    voffA[i] = (unsigned)(R * K + C) * 2u; voffB[i] = (unsigned)(Rb * K + C) * 2u; }
  const size_t kstep = (size_t)(BK * 2);
  const size_t hstep = (size_t)HALF * K * 2;
  const size_t tstep = 2 * hstep;
  const unsigned ldsw = (unsigned)wid * 1024u;
  const int aoff = lds_byte(wr * 64 + fr, fq * 8), boff = lds_byte(wc * 32 + fr, fq * 8);
#define PG8_SA(b, h) (((b) * 2 + (h)) * HTB)
#define PG8_SB(b, h) ((4 + (b) * 2 + (h)) * HTB)
#define PG8_STAGE(bufoff, gbase, voff) do { _Pragma("unroll") for (int _i = 0; _i < 2; ++_i) \
    asm volatile("s_mov_b32 m0, %2\n\ts_nop 0\n\tglobal_load_lds_dwordx4 %0, %1" :: "v"((voff)[_i]), "s"((const char*)(gbase)), "s"((unsigned)(size_t)(lds + (bufoff) + ldsw + _i * 8192)) : "memory", "m0"); } while (0)
#define PG8_LDA(dst, b, h) do { _Pragma("unroll") for (int m = 0; m < 4; ++m) _Pragma("unroll") for (int k = 0; k < 2; ++k) dst[m][k] = *(const LAS bf16x8*)(lds + PG8_SA(b, h) + aoff + m * 2048 + k * 1024); } while (0)
#define PG8_LDB(dst, b, h) do { _Pragma("unroll") for (int n = 0; n < 2; ++n) _Pragma("unroll") for (int k = 0; k < 2; ++k) dst[n][k] = *(const LAS bf16x8*)(lds + PG8_SB(b, h) + boff + n * 2048 + k * 1024); } while (0)
#define PG8_MMA(ai, bj, At, Bt) do { __builtin_amdgcn_s_setprio(1); _Pragma("unroll") for (int m = 0; m < 4; ++m) _Pragma("unroll") for (int n = 0; n < 2; ++n) _Pragma("unroll") for (int k = 0; k < 2; ++k) \
    acc[ai][bj][m][n] = __builtin_amdgcn_mfma_f32_16x16x32_bf16(Bt[n][k], At[m][k], acc[ai][bj][m][n], 0, 0, 0); __builtin_amdgcn_s_setprio(0); } while (0)
#define PG8_WAIT_V(n) asm volatile("s_waitcnt vmcnt(" #n ")" ::: "memory")
#define PG8_WAIT_L(n) asm volatile("s_waitcnt lgkmcnt(" #n ")" ::: "memory")
#define PG8_BAR __builtin_amdgcn_s_barrier()
#define PG8_SCHED __builtin_amdgcn_sched_barrier(0)
  Unit cur, nxt; int ui = 0;
  if (!S.next(0, cur)) return;
  if constexpr (Epi::HAS_RS) {
    LAS float* rsl = (LAS float*)(lds + STAGE_BYTES);
    LAS int* pml = (LAS int*)(lds + STAGE_BYTES + 14 * 1024);
    { Unit u2;
#pragma unroll 1
      for (int i = 0; i < 14; ++i) { const bool ok = S.next(i, u2); if (tid == 0) pml[i] = ok ? u2.pm : -1; } }
    __syncthreads();
#pragma unroll 1
    for (int i0 = 0; i0 < 14; i0 += 7) {
      f32x4 pa[7], pb[7]; int pmv[7];
#pragma unroll
      for (int j = 0; j < 7; ++j) { pmv[j] = pml[i0 + j]; pa[j] = (f32x4){0.f, 0.f, 0.f, 0.f}; pb[j] = pa[j];
        if (pmv[j] >= 0) { const float* sp = E.ssq + (size_t)(pmv[j] * 256 + (tid >> 1)) * 16 + (tid & 1) * 8; pa[j] = *(const f32x4*)sp; pb[j] = *(const f32x4*)(sp + 4); } }
#pragma unroll
      for (int j = 0; j < 7; ++j) { float s = pa[j].x + pa[j].y + pa[j].z + pa[j].w + pb[j].x + pb[j].y + pb[j].z + pb[j].w; s += __shfl_xor(s, 1);
        if (pmv[j] >= 0 && (tid & 1) == 0) rsl[(i0 + j) * 256 + (tid >> 1)] = rsqrtf(s * (1.0f / 1024.0f) + EPS); }
    }
    __syncthreads();
  }
  f32x4 acc[2][2][4][2];
#pragma unroll
  for (int a = 0; a < 2; ++a)
#pragma unroll
    for (int b = 0; b < 2; ++b)
#pragma unroll
      for (int m = 0; m < 4; ++m)
#pragma unroll
        for (int n = 0; n < 2; ++n) acc[a][b][m][n] = (f32x4){0.f, 0.f, 0.f, 0.f};
  bf16x8 At[4][2], B0[2][2], B1[2][2];
  const char* cA = (const char*)(cur.z ? g.A1 : g.A0) + (size_t)cur.pm * tstep; const char* cB = (const char*)(cur.z ? g.B1 : g.B0) + (size_t)cur.pn * tstep;
#if PG8_SP2
  PG8_STAGE(PG8_SB(0, 0), cB, voffB); PG8_STAGE(PG8_SB(0, 1), cB + hstep, voffB); PG8_STAGE(PG8_SA(0, 0), cA, voffA); PG8_STAGE(PG8_SA(0, 1), cA + hstep, voffA);
  if (wr == 1) PG8_BAR;
  PG8_WAIT_V(2); PG8_BAR;
  PG8_STAGE(PG8_SB(1, 0), cB + kstep, voffB); PG8_STAGE(PG8_SA(1, 0), cA + kstep, voffA); PG8_STAGE(PG8_SB(1, 1), cB + hstep + kstep, voffB);
  PG8_WAIT_V(6); PG8_BAR;
#else
  PG8_STAGE(PG8_SB(0, 0), cB, voffB); PG8_STAGE(PG8_SA(0, 0), cA, voffA); PG8_STAGE(PG8_SB(0, 1), cB + hstep, voffB); PG8_STAGE(PG8_SA(0, 1), cA + hstep, voffA);
  if (wr == 1) PG8_BAR;
  PG8_WAIT_V(4); PG8_BAR;
  PG8_STAGE(PG8_SB(1, 0), cB + kstep, voffB); PG8_STAGE(PG8_SA(1, 0), cA + kstep, voffA); PG8_STAGE(PG8_SB(1, 1), cB + hstep + kstep, voffB);
  PG8_WAIT_V(6); PG8_BAR;
#endif
  for (;;) {
    const bool has_next = S.next(ui + 1, nxt);
    const char* nA = has_next ? (const char*)(nxt.z ? g.A1 : g.A0) + (size_t)nxt.pm * tstep : cA; const char* nB = has_next ? (const char*)(nxt.z ? g.B1 : g.B0) + (size_t)nxt.pn * tstep : cB;
    for (int t = 0; t < nt; t += 2) {
      const bool last = (t == nt - 2);
      const char* a1 = cA + (size_t)(t + 1) * kstep;
      const char* a2 = last ? nA : cA + (size_t)(t + 2) * kstep; const char* b2 = last ? nB : cB + (size_t)(t + 2) * kstep;
      const char* a3 = a2 + kstep; const char* b3 = b2 + kstep;
#if PG8_SP2
      PG8_LDB(B0, 0, 0); PG8_LDB(B1, 0, 1); PG8_SCHED; PG8_LDA(At, 0, 0); PG8_STAGE(PG8_SA(1, 1), a1 + hstep, voffA);
      PG8_WAIT_V(8); PG8_WAIT_L(0); PG8_BAR; PG8_MMA(0, 0, At, B0); PG8_MMA(0, 1, At, B1); PG8_BAR; PG8_SCHED;
      PG8_LDA(At, 0, 1); PG8_STAGE(PG8_SB(0, 0), b2, voffB); PG8_STAGE(PG8_SB(0, 1), b2 + hstep, voffB); PG8_STAGE(PG8_SA(0, 0), a2, voffA);
      PG8_WAIT_V(8); PG8_WAIT_L(0); PG8_BAR; PG8_MMA(1, 0, At, B0); PG8_MMA(1, 1, At, B1); PG8_BAR; PG8_SCHED;
      PG8_LDB(B0, 1, 0); PG8_LDB(B1, 1, 1); PG8_SCHED; PG8_LDA(At, 1, 0); PG8_STAGE(PG8_SA(0, 1), a2 + hstep, voffA);
      PG8_WAIT_V(8); PG8_WAIT_L(0); PG8_BAR; PG8_MMA(0, 0, At, B0); PG8_MMA(0, 1, At, B1); PG8_BAR; PG8_SCHED;
      PG8_LDA(At, 1, 1); PG8_STAGE(PG8_SB(1, 0), b3, voffB); PG8_STAGE(PG8_SB(1, 1), b3 + hstep, voffB); PG8_STAGE(PG8_SA(1, 0), a3, voffA);
      PG8_WAIT_V(8); PG8_WAIT_L(0); PG8_BAR; PG8_MMA(1, 0, At, B0); PG8_MMA(1, 1, At, B1); PG8_BAR; PG8_SCHED;
#else
      PG8_LDB(B0, 0, 0); PG8_SCHED; PG8_LDA(At, 0, 0); PG8_STAGE(PG8_SA(1, 1), a1 + hstep, voffA);
      PG8_WAIT_L(8); PG8_BAR; PG8_WAIT_L(0); PG8_MMA(0, 0, At, B0); PG8_BAR; PG8_SCHED;
      PG8_LDB(B1, 0, 1); PG8_STAGE(PG8_SB(0, 0), b2, voffB);
      PG8_BAR; PG8_WAIT_L(0); PG8_MMA(0, 1, At, B1); PG8_BAR;
      PG8_LDA(At, 0, 1); PG8_STAGE(PG8_SA(0, 0), a2, voffA);
      PG8_BAR; PG8_WAIT_L(0); PG8_MMA(1, 0, At, B0); PG8_BAR; PG8_SCHED;
      PG8_STAGE(PG8_SB(0, 1), b2 + hstep, voffB);
      PG8_WAIT_V(6); PG8_BAR; PG8_MMA(1, 1, At, B1); PG8_BAR;
      PG8_LDB(B0, 1, 0); PG8_SCHED; PG8_LDA(At, 1, 0); PG8_STAGE(PG8_SA(0, 1), a2 + hstep, voffA);
      PG8_WAIT_L(8); PG8_BAR; PG8_WAIT_L(0); PG8_MMA(0, 0, At, B0); PG8_BAR; PG8_SCHED;
      PG8_LDB(B1, 1, 1); PG8_STAGE(PG8_SB(1, 0), b3, voffB);
      PG8_BAR; PG8_WAIT_L(0); PG8_MMA(0, 1, At, B1); PG8_BAR;
      PG8_LDA(At, 1, 1); PG8_STAGE(PG8_SA(1, 0), a3, voffA);
      PG8_BAR; PG8_WAIT_L(0); PG8_MMA(1, 0, At, B0); PG8_BAR; PG8_SCHED;
      PG8_STAGE(PG8_SB(1, 1), b3 + hstep, voffB);
      PG8_WAIT_V(6); PG8_BAR; PG8_MMA(1, 1, At, B1); PG8_BAR;
#endif
    }
    if (wr == 0) PG8_BAR;
    { int fr2 = fr, fq2 = fq; asm volatile("" : "+v"(fr2), "+v"(fq2)); E(acc, cur, wr, wc, fr2, fq2, (const LAS float*)(lds + STAGE_BYTES) + ui * 256); }
    if (!has_next) break;
#pragma unroll
    for (int a = 0; a < 2; ++a)
#pragma unroll
      for (int b = 0; b < 2; ++b)
#pragma unroll
        for (int m = 0; m < 4; ++m)
#pragma unroll
          for (int n = 0; n < 2; ++n) acc[a][b][m][n] = (f32x4){0.f, 0.f, 0.f, 0.f};
    cur = nxt; cA = nA; cB = nB; ++ui;
    if (wr == 1) PG8_BAR;
  }
  PG8_WAIT_V(0);
  PG8_BAR;
#undef PG8_SA
#undef PG8_SB
#undef PG8_STAGE
#undef PG8_LDA
#undef PG8_LDB
#undef PG8_MMA
#undef PG8_WAIT_V
#undef PG8_WAIT_L
#undef PG8_BAR
#undef PG8_SCHED
}
}
using pg8::Unit;
typedef f32x4 AccT[2][2][4][2];

DI float row_rs(const float* ssq, int row, int fq) {
  const f32x4 pp = *(const f32x4*)(ssq + (size_t)row * 16 + 4 * fq);
  float s = pp.x + pp.y + pp.z + pp.w; s += __shfl_xor(s, 16); s += __shfl_xor(s, 32);
  return rsqrtf(s * (1.0f / 1024.0f) + EPS);
}

struct Epi1 {
  static constexpr bool DRAIN = true, HAS_RS = true;
  bf16_t *U, *GY, *Q, *Kb, *Vb, *GATES; const float* ssq; const float *b_gate, *g_q, *g_k; float* out; int l;
  template <int REG> DI void body(const AccT& acc, const Unit& u, int wr, int wc, int fr, int fq, const LAS float* rsl) const {
    const int pn = u.pn;
#pragma unroll
    for (int ai = 0; ai < 2; ++ai) {
      float rsv[4];
#pragma unroll
      for (int m = 0; m < 4; ++m) rsv[m] = rsl[ai * 128 + wr * 64 + m * 16 + fr];
      __builtin_amdgcn_sched_barrier(0);
#pragma unroll
      for (int m = 0; m < 4; ++m) {
        const int row = u.pm * 256 + ai * 128 + wr * 64 + m * 16 + fr;
        const float rs = rsv[m];
        float v[2][8];
#pragma unroll
        for (int bj = 0; bj < 2; ++bj)
#pragma unroll
          for (int n = 0; n < 2; ++n)
#pragma unroll
            for (int j = 0; j < 4; ++j) v[bj][4 * n + j] = acc[ai][bj][m][n][j] * rs;
        const bool isp = row < T_P; const int rp = row - T_P;
        const int b = isp ? (row >> 11) : (rp >> 5), t = isp ? (row & 2047) : (rp & 31);
        if constexpr (REG == 0) {
          int ooff = -1;
          if (isp) { if (t >= 2045) ooff = (int)OUT_PLC + ((l * 16 + b) * 3 + (t - 2045)) * 1024; }
          else { if (t >= 29) ooff = (int)OUT_SLC + ((l * 32 + b) * 3 + (t - 29)) * 1024; }
#pragma unroll
          for (int bj = 0; bj < 2; ++bj) {
            const int col = pn * 256 + bj * 128 + wc * 32 + fq * 8;
            *(u32x4*)(U + (size_t)row * 1024 + col) = pack8(v[bj]);
            if (ooff >= 0) { float* o = out + ooff + col; *(f32x4*)o = (f32x4){v[bj][0], v[bj][1], v[bj][2], v[bj][3]}; *(f32x4*)(o + 4) = (f32x4){v[bj][4], v[bj][5], v[bj][6], v[bj][7]}; }
          }
        } else if constexpr (REG == 1) {
#pragma unroll
          for (int bj = 0; bj < 2; ++bj) {
            const int col = (pn - 4) * 256 + bj * 128 + wc * 32 + fq * 8;
            float w[8];
#pragma unroll
            for (int i = 0; i < 8; ++i) w[i] = gelu_tanh(v[bj][i]);
            *(u32x4*)(GY + (size_t)row * 1024 + col) = pack8(w);
          }
        } else if constexpr (REG == 2 || REG == 3) {
          float ss = 0.f;
#pragma unroll
          for (int bj = 0; bj < 2; ++bj)
#pragma unroll
            for (int i = 0; i < 8; ++i) ss += v[bj][i] * v[bj][i];
          ss += __shfl_xor(ss, 16); ss += __shfl_xor(ss, 32);
          const float sc = rsqrtf(ss * (1.0f / 64.0f) + EPS);
          int ooff = -1;
          if (REG == 3) { if (isp) { if (t >= 1920) ooff = (int)OUT_PK + ((l * 16 + b) * 128 + (t - 1920)) * 256; } else ooff = (int)OUT_SK + (l * 1024 + rp) * 256; }
#pragma unroll
          for (int bj = 0; bj < 2; ++bj) {
            const int d0 = 32 * bj + 8 * fq;
            const float* gg = (REG == 2 ? g_q : g_k) + l * 64;
            const f32x4 c0 = *(const f32x4*)(gg + d0), c1 = *(const f32x4*)(gg + d0 + 4);
            float w[8];
#pragma unroll
            for (int i = 0; i < 4; ++i) { w[i] = v[bj][i] * sc * c0[i]; w[4 + i] = v[bj][4 + i] * sc * c1[i]; }
            if (REG == 2) *(u32x4*)(Q + (size_t)row * 1024 + (pn - 8) * 256 + 64 * wc + d0) = pack8(w);
            else {
              *(u32x4*)(Kb + (size_t)row * 256 + 64 * wc + d0) = pack8(w);
              if (ooff >= 0) { float* o = out + ooff + 64 * wc + d0; *(f32x4*)o = (f32x4){w[0], w[1], w[2], w[3]}; *(f32x4*)(o + 4) = (f32x4){w[4], w[5], w[6], w[7]}; }
            }
          }
        } else if constexpr (REG == 4) {
          int ooff = -1;
          if (isp) { if (t >= 1920) ooff = (int)OUT_PV + ((l * 16 + b) * 128 + (t - 1920)) * 256; } else ooff = (int)OUT_SV + (l * 1024 + rp) * 256;
#pragma unroll
          for (int bj = 0; bj < 2; ++bj) {
            const int col = bj * 128 + wc * 32 + fq * 8;
            *(u32x4*)(Vb + (size_t)row * 256 + col) = pack8(v[bj]);
            if (ooff >= 0) { float* o = out + ooff + col; *(f32x4*)o = (f32x4){v[bj][0], v[bj][1], v[bj][2], v[bj][3]}; *(f32x4*)(o + 4) = (f32x4){v[bj][4], v[bj][5], v[bj][6], v[bj][7]}; }
          }
        } else {
#pragma unroll
          for (int bj = 0; bj < 2; ++bj) {
            const int col = (pn - 14) * 256 + bj * 128 + wc * 32 + fq * 8;
            const f32x4 c0 = *(const f32x4*)(b_gate + l * 2048 + col), c1 = *(const f32x4*)(b_gate + l * 2048 + col + 4);
            float w[8];
#pragma unroll
            for (int i = 0; i < 4; ++i) { w[i] = sigmoidf_(v[bj][i] + c0[i]); w[4 + i] = sigmoidf_(v[bj][4 + i] + c1[i]); }
            *(u32x4*)(GATES + (size_t)row * 2048 + col) = pack8(w);
          }
        }
        __builtin_amdgcn_sched_barrier(0);
      }
    }
  }
  DI void operator()(const AccT& acc, const Unit& u, int wr, int wc, int fr, int fq, const LAS float* rsl) const {
    const int pn = u.pn;
    if (pn < 4) body<0>(acc, u, wr, wc, fr, fq, rsl);
    else if (pn < 8) body<1>(acc, u, wr, wc, fr, fq, rsl);
    else if (pn < 12) body<2>(acc, u, wr, wc, fr, fq, rsl);
    else if (pn == 12) body<3>(acc, u, wr, wc, fr, fq, rsl);
    else if (pn == 13) body<4>(acc, u, wr, wc, fr, fq, rsl);
    else body<5>(acc, u, wr, wc, fr, fq, rsl);
  }
};

struct EpiBr {
  static constexpr bool DRAIN = false, HAS_RS = false;
  bf16_t* MIX; const bf16_t* GATES;
  DI void operator()(const AccT& acc, const Unit& u, int wr, int wc, int fr, int fq, const LAS float*) const {
    const int z = u.z;
#pragma unroll
    for (int ai = 0; ai < 2; ++ai) {
      u32x4 gw[4][2], pw[4][2];
#pragma unroll
      for (int m = 0; m < 4; ++m)
#pragma unroll
        for (int bj = 0; bj < 2; ++bj) {
          const int row = u.pm * 256 + ai * 128 + wr * 64 + m * 16 + fr, col = u.pn * 256 + bj * 128 + wc * 32 + fq * 8;
          gw[m][bj] = *(const u32x4*)(GATES + (size_t)row * 2048 + z * 1024 + col);
          pw[m][bj] = (u32x4){0u, 0u, 0u, 0u};
          if (z) pw[m][bj] = *(const u32x4*)(MIX + (size_t)row * 1024 + col);
        }
      __builtin_amdgcn_sched_barrier(0);
#pragma unroll
      for (int m = 0; m < 4; ++m) {
#pragma unroll
        for (int bj = 0; bj < 2; ++bj) {
          const int row = u.pm * 256 + ai * 128 + wr * 64 + m * 16 + fr, col = u.pn * 256 + bj * 128 + wc * 32 + fq * 8;
          const u32x4 g4 = gw[m][bj], p4 = pw[m][bj];
          float w[8];
          w[0] = bflo(g4.x) * acc[ai][bj][m][0][0] + bflo(p4.x); w[1] = bfhi(g4.x) * acc[ai][bj][m][0][1] + bfhi(p4.x);
          w[2] = bflo(g4.y) * acc[ai][bj][m][0][2] + bflo(p4.y); w[3] = bfhi(g4.y) * acc[ai][bj][m][0][3] + bfhi(p4.y);
          w[4] = bflo(g4.z) * acc[ai][bj][m][1][0] + bflo(p4.z); w[5] = bfhi(g4.z) * acc[ai][bj][m][1][1] + bfhi(p4.z);
          w[6] = bflo(g4.w) * acc[ai][bj][m][1][2] + bflo(p4.w); w[7] = bfhi(g4.w) * acc[ai][bj][m][1][3] + bfhi(p4.w);
          *(u32x4*)(MIX + (size_t)row * 1024 + col) = pack8(w);
        }
        __builtin_amdgcn_sched_barrier(0);
      }
    }
  }
};

struct EpiRes {
  static constexpr bool DRAIN = false, HAS_RS = false;
  float* X; bf16_t* XB; float* ssq; bool dry, fin;
  DI void operator()(const AccT& acc, const Unit& u, int wr, int wc, int fr, int fq, const LAS float*) const {
    u32x4 xv[2][4][2];
#pragma unroll
    for (int ai = 0; ai < 2; ++ai)
#pragma unroll
      for (int m = 0; m < 4; ++m)
#pragma unroll
        for (int bj = 0; bj < 2; ++bj)
          xv[ai][m][bj] = *(const u32x4*)(XB + (size_t)(u.pm * 256 + ai * 128 + wr * 64 + m * 16 + fr) * 1024 + u.pn * 256 + bj * 128 + wc * 32 + fq * 8);
    __builtin_amdgcn_sched_barrier(0);
#pragma unroll
    for (int ai = 0; ai < 2; ++ai)
#pragma unroll
      for (int m = 0; m < 4; ++m) {
        const int row = u.pm * 256 + ai * 128 + wr * 64 + m * 16 + fr;
        float ss = 0.f;
#pragma unroll
        for (int bj = 0; bj < 2; ++bj) {
          const int col = u.pn * 256 + bj * 128 + wc * 32 + fq * 8;
          const u32x4 x4 = xv[ai][m][bj];
          float w[8];
          w[0] = bflo(x4.x) + acc[ai][bj][m][0][0]; w[1] = bfhi(x4.x) + acc[ai][bj][m][0][1]; w[2] = bflo(x4.y) + acc[ai][bj][m][0][2]; w[3] = bfhi(x4.y) + acc[ai][bj][m][0][3];
          w[4] = bflo(x4.z) + acc[ai][bj][m][1][0]; w[5] = bfhi(x4.z) + acc[ai][bj][m][1][1]; w[6] = bflo(x4.w) + acc[ai][bj][m][1][2]; w[7] = bfhi(x4.w) + acc[ai][bj][m][1][3];
#pragma unroll
          for (int i = 0; i < 8; ++i) ss += w[i] * w[i];
          if (!dry) {
            if (fin) { float* xp = X + (size_t)row * 1024 + col; *(f32x4*)xp = (f32x4){w[0], w[1], w[2], w[3]}; *(f32x4*)(xp + 4) = (f32x4){w[4], w[5], w[6], w[7]}; }
            else *(u32x4*)(XB + (size_t)row * 1024 + col) = pack8(w);
          }
        }
        ss += __shfl_xor(ss, 16); ss += __shfl_xor(ss, 32);
        if (fq == 0 && (!dry || ss == -1.f)) ssq[(size_t)row * 16 + u.pn * 4 + wc] = ss;
        __builtin_amdgcn_sched_barrier(0);
      }
  }
};

struct EpiUp {
  static constexpr bool DRAIN = false, HAS_RS = true;
  bf16_t* ACT; float *H, *G0, *U0; const float* ssq; const float *wf, *bfc; float* out; int l;
  DI void operator()(const AccT& acc, const Unit& u, int wr, int wc, int fr, int fq, const LAS float* rsl) const {
    const int pn = u.pn, colb = pn * 128 + wc * 32 + fq * 8;
    const bool isp = u.pm < 128;
    float rsv[2][4];
#pragma unroll
    for (int ai = 0; ai < 2; ++ai)
#pragma unroll
      for (int m = 0; m < 4; ++m) rsv[ai][m] = rsl[ai * 128 + wr * 64 + m * 16 + fr];
    float w0[8], w1[8], w2[8], bb[8];
    { const float* wp = wf + (size_t)l * 3 * 3072 + colb; const float* bp = bfc + l * 3072 + colb;
      const f32x4 a0 = *(const f32x4*)wp, a1 = *(const f32x4*)(wp + 4), b0 = *(const f32x4*)(wp + 3072), b1 = *(const f32x4*)(wp + 3076), c0 = *(const f32x4*)(wp + 6144), c1 = *(const f32x4*)(wp + 6148), d0 = *(const f32x4*)bp, d1 = *(const f32x4*)(bp + 4);
#pragma unroll
      for (int i = 0; i < 4; ++i) { w0[i] = a0[i]; w0[4 + i] = a1[i]; w1[i] = b0[i]; w1[4 + i] = b1[i]; w2[i] = c0[i]; w2[4 + i] = c1[i]; bb[i] = d0[i]; bb[4 + i] = d1[i]; }
#pragma unroll
      for (int i = 0; i < 8; ++i) asm volatile("" : "+v"(w0[i]), "+v"(w1[i]), "+v"(w2[i]), "+v"(bb[i])); }
    __builtin_amdgcn_s_waitcnt(0x0F70);
    __builtin_amdgcn_sched_barrier(0);
    const int lane = fr + 16 * fq, src1 = (lane & 48) | ((lane - 1) & 15), src2 = (lane & 48) | ((lane - 2) & 15);
#pragma unroll
    for (int ai = 0; ai < 2; ++ai) {
      float pA1[8], pA2[8];
#pragma unroll
      for (int i = 0; i < 8; ++i) { pA1[i] = 0.f; pA2[i] = 0.f; }
#pragma unroll
      for (int m = 0; m < 4; ++m) {
        const int row = u.pm * 256 + ai * 128 + wr * 64 + m * 16 + fr;
        const float rs = rsv[ai][m];
        float g[8], up[8], A1[8], A2[8];
#pragma unroll
        for (int i = 0; i < 4; ++i) { g[i] = acc[ai][0][m][0][i] * rs; g[4 + i] = acc[ai][0][m][1][i] * rs; up[i] = acc[ai][1][m][0][i] * rs; up[4 + i] = acc[ai][1][m][1][i] * rs; }
#pragma unroll
        for (int i = 0; i < 8; ++i) {
          A1[i] = __builtin_bit_cast(float, __builtin_amdgcn_update_dpp(0, __builtin_bit_cast(int, g[i]), 0x121, 0xf, 0xf, false));
          A2[i] = __builtin_bit_cast(float, __builtin_amdgcn_update_dpp(0, __builtin_bit_cast(int, g[i]), 0x122, 0xf, 0xf, false)); }
        const bool deferred = fr < 2 && (m == 0 || (!isp && m == 2));
        if (!deferred) {
          float o[8];
#pragma unroll
          for (int i = 0; i < 8; ++i) { const float p1 = fr >= 1 ? A1[i] : pA1[i], p2 = fr >= 2 ? A2[i] : pA2[i]; o[i] = gelu_tanh(bb[i] + w0[i] * p2 + w1[i] * p1 + w2[i] * g[i]) * up[i]; }
          *(u32x4*)(ACT + (size_t)row * 3072 + colb) = pack8(o);
        } else {
          const size_t so = ((size_t)(row >> 5) * 2 + (row & 1)) * 3072 + colb;
          *(f32x4*)(G0 + so) = (f32x4){g[0], g[1], g[2], g[3]}; *(f32x4*)(G0 + so + 4) = (f32x4){g[4], g[5], g[6], g[7]};
          *(f32x4*)(U0 + so) = (f32x4){up[0], up[1], up[2], up[3]}; *(f32x4*)(U0 + so + 4) = (f32x4){up[4], up[5], up[6], up[7]};
        }
        if (fr >= 14 && (m == 3 || (!isp && m == 1))) {
          if (m == 3) { const size_t ho = ((size_t)(row >> 6) * 2 + (fr - 14)) * 3072 + colb;
            *(f32x4*)(H + ho) = (f32x4){g[0], g[1], g[2], g[3]}; *(f32x4*)(H + ho + 4) = (f32x4){g[4], g[5], g[6], g[7]}; }
          int ooff = -1;
          if (isp) { const int t = row & 2047; if (t >= 2046) ooff = (int)OUT_PFC + ((l * 16 + (row >> 11)) * 2 + (t - 2046)) * 3072; }
          else { const int rp = row - T_P, t = rp & 31; if (t >= 30) ooff = (int)OUT_SFC + ((l * 32 + (rp >> 5)) * 2 + (t - 30)) * 3072; }
          if (ooff >= 0) { float* o = out + ooff + colb; *(f32x4*)o = (f32x4){g[0], g[1], g[2], g[3]}; *(f32x4*)(o + 4) = (f32x4){g[4], g[5], g[6], g[7]}; }
        }
#pragma unroll
        for (int i = 0; i < 8; ++i) { pA1[i] = A1[i]; pA2[i] = A2[i]; }
        __builtin_amdgcn_sched_barrier(0);
      }
    }
  }
};

DI void sg_partial(const int tid, LAS float* red, const bf16_t* A, const bf16_t* B, const int K, const int row0, const int col0, f32x4 (&res)[2]) {
  const int wave = tid >> 6, lane = tid & 63, r = lane & 15, kq = lane >> 4;
  const int KW = K >> 3;
  f32x4 acc[4][4];
#pragma unroll
  for (int rb = 0; rb < 4; ++rb)
#pragma unroll
    for (int cb = 0; cb < 4; ++cb) acc[rb][cb] = (f32x4){0.f, 0.f, 0.f, 0.f};
  const bf16_t* ap = A + (size_t)(row0 + r) * K + wave * KW + 8 * kq;
  const bf16_t* bp = B + (size_t)(col0 + r) * K + wave * KW + 8 * kq;
#pragma unroll 1
  for (int k = 0; k < KW; k += 128) {
    bf16x8 af[4][4], bfr[4][4];
#pragma unroll
    for (int s = 0; s < 4; ++s)
#pragma unroll
      for (int q = 0; q < 4; ++q) { af[s][q] = *(const bf16x8*)(ap + (size_t)q * 16 * K + k + 32 * s); bfr[s][q] = *(const bf16x8*)(bp + (size_t)q * 16 * K + k + 32 * s); }
#pragma unroll
    for (int s = 0; s < 4; ++s)
#pragma unroll
      for (int rb = 0; rb < 4; ++rb)
#pragma unroll
        for (int cb = 0; cb < 4; ++cb) acc[rb][cb] = __builtin_amdgcn_mfma_f32_16x16x32_bf16(bfr[s][cb], af[s][rb], acc[rb][cb], 0, 0, 0);
  }
  __syncthreads();
#pragma unroll
  for (int rb = 0; rb < 4; ++rb)
#pragma unroll
    for (int cb = 0; cb < 4; ++cb) *(LAS f32x4*)(red + ((wave * 16 + rb * 4 + cb) * 64 + lane) * 4) = acc[rb][cb];
  __syncthreads();
#pragma unroll
  for (int h = 0; h < 2; ++h) {
    const int blk = (wave >> 1) * 4 + 2 * (wave & 1) + h;
    f32x4 s = *(const LAS f32x4*)(red + ((0 * 16 + blk) * 64 + lane) * 4);
#pragma unroll
    for (int w2 = 1; w2 < 8; ++w2) s += *(const LAS f32x4*)(red + ((w2 * 16 + blk) * 64 + lane) * 4);
    res[h] = s;
  }
}
template <int MODE>
DI void small_gemm(const int tid, LAS unsigned char* lds, const int tile, const bf16_t* A0, const bf16_t* B0, const bf16_t* A1, const bf16_t* B1, const int K,
                   bf16_t* MIX, const bf16_t* GATES, float* X, bf16_t* XB, float* ssq, const bool dry, const bool fin) {
  const int wave = tid >> 6, lane = tid & 63, r = lane & 15, kq = lane >> 4;
  const int tm = tile >> 4, tn = tile & 15, row0 = T_P + tm * 64, col0 = tn * 64;
  LAS float* red = (LAS float*)lds;
  LAS float* ssp = (LAS float*)(lds + 131072);
  const int row = row0 + 16 * (wave >> 1) + r;
  f32x4 c0[2];
  sg_partial(tid, red, A0, B0, K, row0, col0, c0);
  if constexpr (MODE == 0) {
    f32x4 c1[2];
    sg_partial(tid, red, A1, B1, K, row0, col0, c1);
#pragma unroll
    for (int h = 0; h < 2; ++h) {
      const int col = col0 + 16 * (2 * (wave & 1) + h) + 4 * kq;
      const u32x2 g0 = *(const u32x2*)(GATES + (size_t)row * 2048 + col), g1 = *(const u32x2*)(GATES + (size_t)row * 2048 + 1024 + col);
      u32x2 w;
      w.x = pk2(bflo(g0.x) * c0[h][0] + bflo(g1.x) * c1[h][0], bfhi(g0.x) * c0[h][1] + bfhi(g1.x) * c1[h][1]);
      w.y = pk2(bflo(g0.y) * c0[h][2] + bflo(g1.y) * c1[h][2], bfhi(g0.y) * c0[h][3] + bfhi(g1.y) * c1[h][3]);
      *(u32x2*)(MIX + (size_t)row * 1024 + col) = w;
    }
  } else {
    float ss = 0.f;
#pragma unroll
    for (int h = 0; h < 2; ++h) {
      const int col = col0 + 16 * (2 * (wave & 1) + h) + 4 * kq;
      const u32x2 xb2 = *(const u32x2*)(XB + (size_t)row * 1024 + col);
      const f32x4 w = (f32x4){bflo(xb2.x), bfhi(xb2.x), bflo(xb2.y), bfhi(xb2.y)} + c0[h];
      ss += w[0] * w[0] + w[1] * w[1] + w[2] * w[2] + w[3] * w[3];
      if (!dry) { if (fin) *(f32x4*)(X + (size_t)row * 1024 + col) = w; else { u32x2 wb; wb.x = pk2(w[0], w[1]); wb.y = pk2(w[2], w[3]); *(u32x2*)(XB + (size_t)row * 1024 + col) = wb; } }
    }
    ss += __shfl_xor(ss, 16); ss += __shfl_xor(ss, 32);
    if (kq == 0) ssp[wave * 16 + r] = ss;
    __syncthreads();
    if (kq == 0 && (wave & 1) == 0 && (!dry || ss == -1.f)) ssq[(size_t)row * 16 + tn] = ss + ssp[(wave + 1) * 16 + r];
  }
  __syncthreads();
}

struct TrDesc { const float* src; const float* gvec; bf16_t* dst; int ldsrc, k0, n0, lddst, drow0, hperm; };
DI TrDesc tr_decode(int tile, const Params& p, unsigned char* ws) {
  constexpr int PER_L = 1408 + 256 * 3 + 1536 + 768 + 32;
  const int l = tile / PER_L; int r = tile % PER_L;
  TrDesc d;
  if (r < 1408) {
    const int kt = r / 88, ntl = r % 88, n0 = ntl * 64;
    const bool qk = (n0 >= 2048 && n0 < 3328);
    d.src = p.in[8] + (size_t)l * DM * DIN; d.ldsrc = DIN; d.k0 = kt * 64; d.n0 = n0; d.gvec = p.in[7] + l * DM; d.dst = (bf16_t*)(ws + WS_WIN + l * SZ_WIN); d.lddst = DM;
    d.drow0 = qk ? (n0 & ~255) : n0; d.hperm = qk ? ((n0 & 255) >> 6) : -1;
    return d; }
  r -= 1408;
  if (r < 768) {
    const int which = r >> 8, rr = r & 255, kt = rr >> 4, ntl = rr & 15;
    d.src = (which == 0 ? p.in[20] : (which == 1 ? p.in[21] : p.in[22])) + (size_t)l * DM * DM;
    d.dst = which < 2 ? (bf16_t*)(ws + WS_WBR + (size_t)(2 * l + which) * SZ_WSQ) : (bf16_t*)(ws + WS_WOUT + l * SZ_WSQ);
    d.ldsrc = DM; d.k0 = kt * 64; d.n0 = ntl * 64; d.gvec = nullptr; d.lddst = DM; d.drow0 = ntl * 64; d.hperm = -1;
    return d; }
  r -= 768;
  if (r < 1536) {
    const int kt = r / 96, ntl = r % 96;
    d.src = p.in[24] + (size_t)l * DM * 2 * DFF; d.ldsrc = 2 * DFF; d.k0 = kt * 64; d.n0 = ntl * 64; d.gvec = p.in[23] + l * DM; d.dst = (bf16_t*)(ws + WS_WUP + l * SZ_WUP); d.lddst = DM;
    d.drow0 = (((ntl * 64) % DFF) >> 7) * 256 + ((ntl * 64) >= DFF ? 128 : 0) + ((ntl * 64) & 64); d.hperm = -1;
    return d; }
  r -= 1536;
  if (r < 768) {
    const int kt = r >> 4, ntl = r & 15;
    d.src = p.in[27] + (size_t)l * DFF * DM; d.ldsrc = DM; d.k0 = kt * 64; d.n0 = ntl * 64; d.gvec = nullptr; d.dst = (bf16_t*)(ws + WS_WDN + l * SZ_WDN); d.lddst = DFF; d.drow0 = ntl * 64; d.hperm = -1;
    return d; }
  r -= 768;
  {
    const int which = r >> 4, nb = r & 15;
    d.src = (which ? p.in[14] : p.in[12]) + (size_t)l * 65536 + nb * 4096;
    d.dst = (bf16_t*)(ws + (which ? WS_WI : WS_WA) + l * SZ_WBD) + nb * 4096;
    d.ldsrc = 64; d.k0 = 0; d.n0 = 0; d.gvec = nullptr; d.lddst = 64; d.drow0 = 0; d.hperm = -1;
    return d; }
}

DI int tr_tile_id(const int mode, const int L, const int idx) {
  if (mode == 0) return L * 4512 + idx;
  if (mode == 1) return L * 4512 + (idx < 2304 ? 1408 + idx : 4480 + (idx - 2304));
  return idx < 768 ? L * 4512 + 3712 + idx : (L + 1) * 4512 + (idx - 768);
}
DI void tr_range(const int tid, LAS unsigned char* lds, const Params& p, unsigned char* ws, const int mode, const int L, const int first_idx, const int count, const int stride) {
  LAS float* tl = (LAS float*)lds;
  const int kk = tid >> 3, n8 = (tid & 7) * 8;
#define TR_LOAD(D, A, B, GS) do { const float* sp_ = (D).src + (size_t)((D).k0 + kk) * (D).ldsrc + (D).n0 + n8; A = *(const f32x4*)sp_; B = *(const f32x4*)(sp_ + 4); GS = (D).gvec ? (D).gvec[(D).k0 + kk] : 1.0f; } while (0)
  f32x4 ca = {0.f, 0.f, 0.f, 0.f}, cb = {0.f, 0.f, 0.f, 0.f}; float cg = 1.f;
  TrDesc d = tr_decode(tr_tile_id(mode, L, first_idx), p, ws);
  if (count > 0) TR_LOAD(d, ca, cb, cg);
  for (int j = 0; j < count; ++j) {
    f32x4 na = {0.f, 0.f, 0.f, 0.f}, nb = {0.f, 0.f, 0.f, 0.f}; float ng = 1.f;
    const bool has = j + 1 < count;
    TrDesc dn = tr_decode(tr_tile_id(mode, L, first_idx + (has ? j + 1 : j) * stride), p, ws);
    if (has) TR_LOAD(dn, na, nb, ng);
    { LAS float* tp = tl + kk * 65 + n8;
      tp[0] = ca[0] * cg; tp[1] = ca[1] * cg; tp[2] = ca[2] * cg; tp[3] = ca[3] * cg; tp[4] = cb[0] * cg; tp[5] = cb[1] * cg; tp[6] = cb[2] * cg; tp[7] = cb[3] * cg; }
    __syncthreads();
    { const int nn = tid >> 3, k8 = (tid & 7) * 8;
      float w[8];
#pragma unroll
      for (int i = 0; i < 8; ++i) w[i] = tl[(k8 + i) * 65 + nn];
      const int dr = d.hperm >= 0 ? (128 * (nn >> 5) + 32 * d.hperm + (nn & 31)) : nn;
      *(u32x4*)(d.dst + (size_t)(d.drow0 + dr) * d.lddst + d.k0 + k8) = pack8(w); }
    __syncthreads();
    d = dn; ca = na; cb = nb; cg = ng;
  }
#undef TR_LOAD
}

DI void phase_prep(const int tid_in, const int bx, const int G, LAS unsigned char* lds, const Params& p, unsigned char* ws, float* out) {
  int tid = tid_in; asm volatile("" : "+v"(tid));
  { const int cnt = bx < 1408 ? (1408 - bx + G - 1) / G : 0; tr_range(tid, lds, p, ws, 0, 0, bx, cnt, G); }
  const int wave = tid >> 6, lane = tid & 63;
  float* X = out; bf16_t* XB = (bf16_t*)(ws + WS_XB); float* ssq = (float*)(ws + WS_SSQ);
  for (int row = bx * 8 + wave; row < T_ALL; row += G * 8) {
    const float* src = row < T_P ? p.in[0] + (size_t)row * DM : p.in[1] + (size_t)(row - T_P) * DM;
    float ss = 0.f;
#pragma unroll
    for (int i = 0; i < 2; ++i) {
      const int col = i * 512 + lane * 8;
      const f32x4 a = *(const f32x4*)(src + col), b = *(const f32x4*)(src + col + 4);
      float w[8] = {a[0], a[1], a[2], a[3], b[0], b[1], b[2], b[3]};
#pragma unroll
      for (int j = 0; j < 8; ++j) ss += w[j] * w[j];
      *(u32x4*)(XB + (size_t)row * DM + col) = pack8(w);
    }
#pragma unroll
    for (int o = 32; o >= 1; o >>= 1) ss += __shfl_xor(ss, o);
    if (lane < 16) ssq[(size_t)row * 16 + lane] = lane == 0 ? ss : 0.f;
  }
}

DI void lru_item(const int tid, LAS unsigned char* lds, const Params& p, unsigned char* ws, float* out, int l, int seq, int cb, bool dry) {
  const int wave = tid >> 6, lane = tid & 63;
  LAS float* XCF = (LAS float*)(lds);
  LAS float* AS = (LAS float*)(lds + 32768);
  LAS float* BS = (LAS float*)(lds + 65536);
  LAS bf16_t* XCB = (LAS bf16_t*)(lds + 98304);
  LAS bf16_t* WA = (LAS bf16_t*)(lds + 116736);
  LAS bf16_t* WI = (LAS bf16_t*)(lds + 125952);
  LAS float* SEGA = (LAS float*)(lds + 135168);
  LAS float* SEGB = (LAS float*)(lds + 137216);
  LAS float* HC = (LAS float*)(lds + 139264);
  LAS float* WC = (LAS float*)(lds + 139776);

  const bool isp = seq < 16; const int b = isp ? seq : seq - 16;
  const int row0 = isp ? seq * 2048 : T_P + b * 32;
  const int nchunks = isp ? 16 : 1, nrows = isp ? 128 : 32;
  const bf16_t* U = (const bf16_t*)(ws + WS_U); bf16_t* GY = (bf16_t*)(ws + WS_GY);
  const int c0 = cb * 64;
  __syncthreads();
  { const bf16_t* wa = (const bf16_t*)(ws + WS_WA + l * SZ_WBD) + cb * 4096; const bf16_t* wi = (const bf16_t*)(ws + WS_WI + l * SZ_WBD) + cb * 4096;
    const int n = tid >> 3, k8 = (tid & 7) * 8;
    *(LAS u32x4*)(WA + n * 72 + k8) = *(const u32x4*)(wa + n * 64 + k8);
    *(LAS u32x4*)(WI + n * 72 + k8) = *(const u32x4*)(wi + n * 64 + k8);
    if (tid < 320) { const int j = tid >> 6, c = tid & 63; WC[tid] = j < 4 ? p.in[10][(size_t)(l * 4 + j) * 1024 + c0 + c] : p.in[11][l * 1024 + c0 + c]; }
    if (tid < 64) HC[tid] = isp ? 0.f : p.in[3][(size_t)(l * 32 + b) * 1024 + c0 + tid]; }
  LAS float* GC = (LAS float*)(lds + 141056);
  if (tid < 64) { const int col = l * 1024 + c0 + tid; GC[tid] = p.in[13][col]; GC[64 + tid] = p.in[15][col]; GC[128 + tid] = -8.0f * log1pf(expf(-p.in[16][col])); }
  __syncthreads();

  u32x4 up[2][4];
#define LRU_ISSUE_U(T0) do { _Pragma("unroll") for (int pass = 0; pass < 2; ++pass) { const int row_ = pass * 64 + (tid >> 3); if (row_ < nrows) { \
      _Pragma("unroll") for (int j = 0; j < 4; ++j) { const int tt_ = (T0) + row_ - 3 + j; up[pass][j] = *(const u32x4*)(U + (size_t)(row0 + (tt_ < 0 ? 0 : tt_)) * 1024 + c0 + (tid & 7) * 8); } } } } while (0)
#pragma unroll
  for (int pass = 0; pass < 2; ++pass)
#pragma unroll
    for (int j = 0; j < 4; ++j) up[pass][j] = (u32x4){0u, 0u, 0u, 0u};
  LRU_ISSUE_U(0);
  for (int ch = 0; ch < nchunks; ++ch) {
    const int t0 = ch * 128;
    const int sc = tid & 63, seg = tid >> 6;
    const bool act = seg * 16 < nrows;
#pragma unroll
    for (int pass = 0; pass < 2; ++pass) {
      const int row = pass * 64 + (tid >> 3), cg = (tid & 7) * 8;
      if (row < nrows) {
        float xc[8];
#pragma unroll
        for (int i = 0; i < 8; ++i) xc[i] = WC[256 + cg + i];
#pragma unroll
        for (int j = 0; j < 4; ++j) {
          const int tt = t0 + row - 3 + j;
          float xe[8];
          const u32x4 a = up[pass][j];
          xe[0] = bflo(a.x); xe[1] = bfhi(a.x); xe[2] = bflo(a.y); xe[3] = bfhi(a.y); xe[4] = bflo(a.z); xe[5] = bfhi(a.z); xe[6] = bflo(a.w); xe[7] = bfhi(a.w);
          if (tt < 0) {
            if (!isp) {
              const float* sp_ = p.in[2] + ((size_t)(l * 32 + b) * 3 + (tt + 3)) * 1024 + c0 + cg;
#pragma unroll
              for (int i = 0; i < 8; ++i) xe[i] = sp_[i];
            } else {
#pragma unroll
              for (int i = 0; i < 8; ++i) xe[i] = 0.f;
            }
          }
#pragma unroll
          for (int i = 0; i < 8; ++i) xc[i] += WC[j * 64 + cg + i] * xe[i];
        }
        *(LAS f32x4*)(XCF + row * 64 + cg) = (f32x4){xc[0], xc[1], xc[2], xc[3]}; *(LAS f32x4*)(XCF + row * 64 + cg + 4) = (f32x4){xc[4], xc[5], xc[6], xc[7]};
        *(LAS u32x4*)(XCB + row * 72 + cg) = pack8(xc);
      }
    }
    if (ch + 1 < nchunks) LRU_ISSUE_U(t0 + 128);
    unsigned short gyr[16];
#pragma unroll
    for (int i = 0; i < 16; ++i) gyr[i] = 0;
    if (act) {
#pragma unroll
      for (int i = 0; i < 16; ++i) gyr[i] = GY[(size_t)(row0 + t0 + seg * 16 + i) * 1024 + c0 + sc];
    }
    __syncthreads();
    if (wave * 16 < nrows) {
      const int ar = wave * 16 + (lane & 15), kq = 8 * (lane >> 4);
      bf16x8 af[2];
#pragma unroll
      for (int ks = 0; ks < 2; ++ks) af[ks] = *(const LAS bf16x8*)(XCB + ar * 72 + 32 * ks + kq);
#pragma unroll
      for (int nt = 0; nt < 4; ++nt) {
        f32x4 accr = {0.f, 0.f, 0.f, 0.f}, acci = {0.f, 0.f, 0.f, 0.f};
#pragma unroll
        for (int ks = 0; ks < 2; ++ks) {
          const bf16x8 bA = *(const LAS bf16x8*)(WA + (16 * nt + (lane & 15)) * 72 + 32 * ks + kq);
          const bf16x8 bI = *(const LAS bf16x8*)(WI + (16 * nt + (lane & 15)) * 72 + 32 * ks + kq);
          accr = __builtin_amdgcn_mfma_f32_16x16x32_bf16(af[ks], bA, accr, 0, 0, 0);
          acci = __builtin_amdgcn_mfma_f32_16x16x32_bf16(af[ks], bI, acci, 0, 0, 0);
        }
#pragma unroll
        for (int j = 0; j < 4; ++j) {
          const int row = wave * 16 + 4 * (lane >> 4) + j, col = 16 * nt + (lane & 15);
          const float r = sigmoidf_(accr[j] + GC[col]), ig = sigmoidf_(acci[j] + GC[64 + col]);
          const float la = GC[128 + col] * r;
          const float a = __builtin_amdgcn_exp2f(la * LOG2E);
          const float x2 = 2.0f * la;
          const float ser = -x2 * (1.0f + x2 * (0.5f + x2 * (0.16666667f + x2 * (0.041666668f + x2 * (0.008333334f + x2 * 0.0013888889f)))));
          const float om = x2 > -0.25f ? ser : 1.0f - a * a;
          AS[row * 64 + col] = a; BS[row * 64 + col] = sqrtf(om) * ig * XCF[row * 64 + col];
        }
      }
    }
    __syncthreads();
    if (act) {
      float A = 1.f, B = 0.f;
#pragma unroll
      for (int i = 0; i < 16; ++i) { const float a = AS[(seg * 16 + i) * 64 + sc], bb = BS[(seg * 16 + i) * 64 + sc]; B = a * B + bb; A *= a; }
      SEGA[seg * 64 + sc] = A; SEGB[seg * 64 + sc] = B;
    }
    __syncthreads();
    if (act) {
      float h = HC[(ch & 1) * 64 + sc];
      { float sa[7], sb[7];
#pragma unroll
        for (int s2 = 0; s2 < 7; ++s2) { sa[s2] = SEGA[s2 * 64 + sc]; sb[s2] = SEGB[s2 * 64 + sc]; }
#pragma unroll
        for (int s2 = 0; s2 < 7; ++s2) if (s2 < seg) h = sa[s2] * h + sb[s2]; }
#pragma unroll
      for (int i = 0; i < 16; ++i) {
        const int r = seg * 16 + i;
        h = AS[r * 64 + sc] * h + BS[r * 64 + sc];
        if (!dry || h == -12345.f) GY[(size_t)(row0 + t0 + r) * 1024 + c0 + sc] = (bf16_t)(pk2(h * bf2f(gyr[i]), 0.f) & 0xffffu);
      }
      if ((seg + 1) * 16 == nrows) {
        HC[((ch + 1) & 1) * 64 + sc] = h;
        if (ch == nchunks - 1 && !dry) out[(isp ? OUT_PLH + (size_t)(l * 16 + b) * 1024 : OUT_SLH + (size_t)(l * 32 + b) * 1024) + c0 + sc] = h;
      }
    }
    __syncthreads();
  }
#undef LRU_ISSUE_U
}

DI void attn_items(const int tid, const int bx, const int G, LAS unsigned char* lds, const Params& p, unsigned char* ws, float* out, int l, bool dry) {
  const int wave = tid >> 6, lane = tid & 63, r = lane & 31, h = lane >> 5;
  LAS bf16_t* KS = (LAS bf16_t*)lds;
  LAS bf16_t* VT = (LAS bf16_t*)(lds + 27648);
  const bf16_t* Kb = (const bf16_t*)(ws + WS_K); const bf16_t* Vb = (const bf16_t*)(ws + WS_V); bf16_t* Q = (bf16_t*)(ws + WS_Q);
  u32x4 kw[3], vw[3]; bf16x8 qf[4];
#pragma unroll
  for (int i = 0; i < 3; ++i) { kw[i] = (u32x4){0u, 0u, 0u, 0u}; vw[i] = (u32x4){0u, 0u, 0u, 0u}; }
#pragma unroll
  for (int s = 0; s < 4; ++s) qf[s] = (bf16x8){0, 0, 0, 0, 0, 0, 0, 0};
#define ATT_LOAD(ID) do { const int id_ = (ID); const bool isp_ = id_ < 2048; const int kvh_ = id_ & 3, b_ = isp_ ? (id_ >> 7) : ((id_ - 2048) >> 2), chunk_ = isp_ ? ((id_ >> 2) & 31) : 0; \
    _Pragma("unroll") for (int i = 0; i < 3; ++i) { const int pc = tid + 512 * i, kk = pc >> 3, d0 = (pc & 7) * 8; \
      kw[i] = (u32x4){0u, 0u, 0u, 0u}; vw[i] = (u32x4){0u, 0u, 0u, 0u}; \
      if (isp_) { const int t = (chunk_ - 2) * 64 + kk; \
        if (t >= 0) { const size_t ro = (size_t)(b_ * 2048 + t) * 256 + kvh_ * 64 + d0; kw[i] = *(const u32x4*)(Kb + ro); vw[i] = *(const u32x4*)(Vb + ro); } \
      } else if (kk < 128) { const size_t co = (((size_t)(l * 32 + b_) * 128 + kk) * 4 + kvh_) * 64 + d0; \
        const f32x4 k0 = *(const f32x4*)(p.in[4] + co), k1 = *(const f32x4*)(p.in[4] + co + 4), v0 = *(const f32x4*)(p.in[5] + co), v1 = *(const f32x4*)(p.in[5] + co + 4); \
        kw[i] = (u32x4){pk2(k0[0], k0[1]), pk2(k0[2], k0[3]), pk2(k1[0], k1[1]), pk2(k1[2], k1[3])}; \
        vw[i] = (u32x4){pk2(v0[0], v0[1]), pk2(v0[2], v0[3]), pk2(v1[0], v1[1]), pk2(v1[2], v1[3])}; \
      } else if (kk < 160) { const size_t ro = (size_t)(T_P + b_ * 32 + (kk - 128)) * 256 + kvh_ * 64 + d0; kw[i] = *(const u32x4*)(Kb + ro); vw[i] = *(const u32x4*)(Vb + ro); } } \
    if (isp_ || wave < 4) { const int g_ = isp_ ? (wave >> 1) : wave; \
      const int qrow_ = isp_ ? (b_ * 2048 + chunk_ * 64 + (wave & 1) * 32 + r) : (T_P + b_ * 32 + r); \
      const bf16_t* qp_ = Q + (size_t)qrow_ * 1024 + (kvh_ * 4 + g_) * 64; \
      _Pragma("unroll") for (int s = 0; s < 4; ++s) qf[s] = *(const bf16x8*)(qp_ + 16 * s + 8 * h); } } while (0)
  int id = bx;
  if (id < 2176) ATT_LOAD(id);
  for (; id < 2176; id += G) {
    const bool isp = id < 2048; const int kvh = id & 3, b = isp ? (id >> 7) : ((id - 2048) >> 2), chunk = isp ? ((id >> 2) & 31) : 0;
    __syncthreads();
#pragma unroll
    for (int i = 0; i < 3; ++i) { const int pc = tid + 512 * i, kk = pc >> 3, d0 = (pc & 7) * 8;
      *(LAS u32x4*)(KS + kk * 72 + d0) = kw[i];
      VT[(d0 + 0) * 200 + kk] = (bf16_t)(vw[i].x & 0xffffu); VT[(d0 + 1) * 200 + kk] = (bf16_t)(vw[i].x >> 16);
      VT[(d0 + 2) * 200 + kk] = (bf16_t)(vw[i].y & 0xffffu); VT[(d0 + 3) * 200 + kk] = (bf16_t)(vw[i].y >> 16);
      VT[(d0 + 4) * 200 + kk] = (bf16_t)(vw[i].z & 0xffffu); VT[(d0 + 5) * 200 + kk] = (bf16_t)(vw[i].z >> 16);
      VT[(d0 + 6) * 200 + kk] = (bf16_t)(vw[i].w & 0xffffu); VT[(d0 + 7) * 200 + kk] = (bf16_t)(vw[i].w >> 16); }
    bf16x8 qc[4];
#pragma unroll
    for (int s = 0; s < 4; ++s) qc[s] = qf[s];
    __syncthreads();
    if (id + G < 2176) ATT_LOAD(id + G);
    const bool active = isp || wave < 4;
    if (active) {
      const int g = isp ? (wave >> 1) : wave, head = kvh * 4 + g;
      const int qrow = isp ? (b * 2048 + chunk * 64 + (wave & 1) * 32 + r) : (T_P + b * 32 + r);
      const int kb_lo = isp ? (chunk >= 2 ? 0 : 2 * (2 - chunk)) : 0, kb_hi = isp ? 6 : 5;
      bf16_t* qp = Q + (size_t)qrow * 1024 + head * 64;
      f32x16 st[6];
#pragma unroll
      for (int kb = 0; kb < 6; ++kb) {
#pragma unroll
        for (int i = 0; i < 16; ++i) st[kb][i] = 0.f;
#pragma unroll
        for (int s = 0; s < 4; ++s) {
          const bf16x8 kf = *(const LAS bf16x8*)(KS + (32 * kb + r) * 72 + 16 * s + 8 * h);
          st[kb] = __builtin_amdgcn_mfma_f32_32x32x16_bf16(kf, qc[s], st[kb], 0, 0, 0);
        }
      }
      const float sinkv = p.in[19][l * 16 + head] * LOG2E;
      const float sscale = 0.125f * LOG2E;
      float mx = sinkv;
#pragma unroll
      for (int kb = 0; kb < 6; ++kb) { const bool valid = kb >= kb_lo && kb < kb_hi;
#pragma unroll
        for (int i = 0; i < 16; ++i) { const float tv = valid ? st[kb][i] * sscale : -1e30f; st[kb][i] = tv; mx = fmaxf(mx, tv); } }
      mx = fmaxf(mx, __shfl_xor(mx, 32));
      float sum = 0.f;
#pragma unroll
      for (int kb = 0; kb < 6; ++kb)
#pragma unroll
        for (int i = 0; i < 16; ++i) { const float pv = __builtin_amdgcn_exp2f(st[kb][i] - mx); st[kb][i] = pv; sum += pv; }
      sum += __shfl_xor(sum, 32);
      sum += __builtin_amdgcn_exp2f(sinkv - mx);
      const float inv = 1.0f / sum;
      f32x16 ot[2];
#pragma unroll
      for (int db = 0; db < 2; ++db)
#pragma unroll
        for (int i = 0; i < 16; ++i) ot[db][i] = 0.f;
#pragma unroll
      for (int kb = 0; kb < 6; ++kb)
#pragma unroll
        for (int s = 0; s < 2; ++s) {
          u32x4 pw; pw.x = pk2(st[kb][8 * s + 0], st[kb][8 * s + 1]); pw.y = pk2(st[kb][8 * s + 2], st[kb][8 * s + 3]); pw.z = pk2(st[kb][8 * s + 4], st[kb][8 * s + 5]); pw.w = pk2(st[kb][8 * s + 6], st[kb][8 * s + 7]);
          const bf16x8 pf = __builtin_bit_cast(bf16x8, pw);
#pragma unroll
          for (int db = 0; db < 2; ++db) {
            const LAS bf16_t* vp = VT + (32 * db + r) * 200 + 32 * kb + 16 * s + 4 * h;
            const u32x2 lo = *(const LAS u32x2*)vp, hi = *(const LAS u32x2*)(vp + 8);
            const u32x4 vv = {lo.x, lo.y, hi.x, hi.y};
            ot[db] = __builtin_amdgcn_mfma_f32_32x32x16_bf16(__builtin_bit_cast(bf16x8, vv), pf, ot[db], 0, 0, 0);
          }
        }
#pragma unroll
      for (int db = 0; db < 2; ++db)
#pragma unroll
        for (int gg = 0; gg < 4; ++gg) {
          u32x2 w; w.x = pk2(ot[db][4 * gg + 0] * inv, ot[db][4 * gg + 1] * inv); w.y = pk2(ot[db][4 * gg + 2] * inv, ot[db][4 * gg + 3] * inv);
          if (!dry || inv == -12345.f) *(u32x2*)(qp + 32 * db + 8 * gg + 4 * h) = w;
        }
    }
  }
#undef ATT_LOAD
}

DI void phase_mixers(const int tid_in, const int bx, const int G, LAS unsigned char* lds, const Params& p, unsigned char* ws, float* out, int l, bool dry) {
  int tid = tid_in; asm volatile("" : "+v"(tid));
  if (!dry || !(REP_MASK & 512)) for (int it = bx; it < 768; it += G) lru_item(tid, lds, p, ws, out, l, it >> 4, it & 15, dry);
  if (!dry || !(REP_MASK & 256)) attn_items(tid, bx, G, lds, p, ws, out, l, dry);
  __syncthreads();
}

DI void phase_ffnfix(const int tid_in, const int bx, const int G, const Params& p, unsigned char* ws, int l, bool dry) {
  int tid = tid_in; asm volatile("" : "+v"(tid));
  bf16_t* ACT = (bf16_t*)(ws + WS_UP); const float* H = (const float*)(ws + WS_H); const float* G0 = (const float*)(ws + WS_G0); const float* U0 = (const float*)(ws + WS_U0);
  const int gt = bx * 512 + tid, nthr = (G * 512 / 384) * 384;
  if (gt >= nthr) return;
  const int c8 = (gt % 384) * 8, d0 = gt / 384, dstep = nthr / 384;
  f32x4 wv[4][2];
#pragma unroll
  for (int j = 0; j < 3; ++j) { wv[j][0] = *(const f32x4*)(p.in[25] + (size_t)(l * 3 + j) * 3072 + c8); wv[j][1] = *(const f32x4*)(p.in[25] + (size_t)(l * 3 + j) * 3072 + c8 + 4); }
  wv[3][0] = *(const f32x4*)(p.in[26] + l * 3072 + c8); wv[3][1] = *(const f32x4*)(p.in[26] + l * 3072 + c8 + 4);
  f32x4 gv[4][2], uv[4][2], p1v[4][2], p2v[4][2]; bool z1[4], z2[4]; int rows[4];
#pragma unroll
  for (int k4 = 0; k4 < 4; ++k4) {
    int d = d0 + k4 * dstep; const bool valid = d < 1088; if (!valid) d = 0;
    const int k = d & 1; const bool isp = d < 1024;
    const int row = isp ? (d >> 1) * 64 + k : T_P + ((d - 1024) >> 1) * 32 + k;
    const int t = isp ? (row & 2047) : ((row - T_P) & 31);
    rows[k4] = valid ? row : -1;
    const size_t so = ((size_t)(row >> 5) * 2 + k) * 3072 + c8;
    const float* st = p.in[6] + ((size_t)(l * 32 + (isp ? 0 : ((row - T_P) >> 5))) * 2) * 3072 + c8;
    const float* hp = H + ((size_t)(isp && t >= 64 ? (row >> 6) - 1 : 0) * 2) * 3072 + c8;
    const float *s1, *s2; z1[k4] = false; z2[k4] = false;
    if (k == 0) { if (t == 0) { s1 = st + 3072; s2 = st; z1[k4] = z2[k4] = isp; } else { s1 = hp + 3072; s2 = hp; } }
    else { s1 = G0 + so - 3072; if (t == 1) { s2 = st + 3072; z2[k4] = isp; } else s2 = hp + 3072; }
    gv[k4][0] = *(const f32x4*)(G0 + so); gv[k4][1] = *(const f32x4*)(G0 + so + 4); uv[k4][0] = *(const f32x4*)(U0 + so); uv[k4][1] = *(const f32x4*)(U0 + so + 4);
    p1v[k4][0] = *(const f32x4*)s1; p1v[k4][1] = *(const f32x4*)(s1 + 4); p2v[k4][0] = *(const f32x4*)s2; p2v[k4][1] = *(const f32x4*)(s2 + 4);
  }
#pragma unroll
  for (int k4 = 0; k4 < 4; ++k4) {
    float o[8];
#pragma unroll
    for (int q = 0; q < 2; ++q)
#pragma unroll
      for (int i = 0; i < 4; ++i) {
        const float a1 = z1[k4] ? 0.f : p1v[k4][q][i], a2 = z2[k4] ? 0.f : p2v[k4][q][i];
        o[4 * q + i] = gelu_tanh(wv[3][q][i] + wv[0][q][i] * a2 + wv[1][q][i] * a1 + wv[2][q][i] * gv[k4][q][i]) * uv[k4][q][i];
      }
    if (rows[k4] >= 0 && (!dry || o[0] == -12345.f)) *(u32x4*)(ACT + (size_t)rows[k4] * 3072 + c8) = pack8(o);
  }
}

#define XB_TMO      128
#define XB_XCNT(j)  (256  + 64 * (j))
#define XB_XSUB(j)  (1280 + 64 * (j))
#define XB_XGEN(j)  (2304 + 64 * (j))
#define XB_TOP      3328
#define XB_TOPGEN   3392
#define XCD_BAR_WORDS 3456
#define XB_SPIN_CAP (1u << 18)
DI unsigned xb_ld(unsigned* p) { return __hip_atomic_load(p, __ATOMIC_RELAXED, __HIP_MEMORY_SCOPE_AGENT); }
DI unsigned xb_add(unsigned* p, unsigned v) { return __hip_atomic_fetch_add(p, v, __ATOMIC_RELAXED, __HIP_MEMORY_SCOPE_AGENT); }
DI unsigned xb_xcc_id() { return (unsigned)__builtin_amdgcn_s_getreg((3 << 11) | 20) & 0xFu; }
#define XB_SPIN(cond, bar) do { unsigned _sp = 0; while (cond) { __builtin_amdgcn_s_sleep(1); \
    if ((++_sp & 255u) == 0u) { if (xb_ld(&(bar)[XB_TMO])) break; if (_sp > XB_SPIN_CAP) { atomicAdd(&(bar)[XB_TMO], 1u); break; } } } } while (0)
DI void xcd_barrier_complete(unsigned* bar, unsigned x, unsigned G, unsigned& nloc, unsigned& nx) {
  unsigned sum, cnt, mine, sp = 0u;
  for (;;) {
    sum = 0u; cnt = 0u; mine = 0u;
#pragma unroll
    for (unsigned j = 0; j < 16; ++j) { const unsigned c = xb_ld(&bar[XB_XCNT(j)]); sum += c; cnt += (c > 0u) ? 1u : 0u; mine = (j == x) ? c : mine; }
    if (sum == G) break;
    __builtin_amdgcn_s_sleep(1);
    if ((++sp & 255u) == 0u) { if (xb_ld(&bar[XB_TMO])) break; if (sp > XB_SPIN_CAP) { atomicAdd(&bar[XB_TMO], 1u); break; } }
  }
  nloc = mine > 0u ? mine : 1u; nx = cnt > 0u ? cnt : 1u;
}
DI void xcd_barrier(const int tid, unsigned* bar, volatile LAS unsigned* st, const unsigned G) {
  asm volatile("s_waitcnt vmcnt(0)" ::: "memory");
  __syncthreads();
  if (tid == 0) {
    const unsigned x = xb_xcc_id();
    __builtin_amdgcn_s_waitcnt(0);
    unsigned nloc = st[0], nx = st[1];
    if (nloc == 0u) { xcd_barrier_complete(bar, x, G, nloc, nx); st[0] = nloc; st[1] = nx; }
    const unsigned old = xb_add(&bar[XB_XSUB(x)], 1u);
    const unsigned gen = old / nloc;
    if (old + 1u == (gen + 1u) * nloc) {
      __builtin_amdgcn_fence(__ATOMIC_RELEASE, "agent");
      asm volatile("s_waitcnt vmcnt(0)" ::: "memory");
      const unsigned og = xb_add(&bar[XB_TOP], 1u);
      const unsigned tg = og / nx;
      if (og + 1u == (tg + 1u) * nx) xb_add(&bar[XB_TOPGEN], 1u);
      else XB_SPIN(xb_ld(&bar[XB_TOPGEN]) == tg, bar);
      __builtin_amdgcn_fence(__ATOMIC_ACQUIRE, "agent");
      xb_add(&bar[XB_XGEN(x)], 1u);
      asm volatile("s_waitcnt vmcnt(0)" ::: "memory");
    } else {
      XB_SPIN(xb_ld(&bar[XB_XGEN(x)]) == gen, bar);
      __builtin_amdgcn_fence(__ATOMIC_ACQUIRE, "agent");
      asm volatile("s_waitcnt vmcnt(0)" ::: "memory");
    }
  }
  __syncthreads();
}

constexpr int N_PHASES = 1 + 7 * 4;
constexpr int LDS_BYTES = 147456;

__global__ void __launch_bounds__(512, 2) mk_fwd(Params p0) {
  extern __shared__ __attribute__((aligned(16))) unsigned char lds_raw[];
  LAS unsigned char* lds = (LAS unsigned char*)lds_raw;
  cg::grid_group grid = cg::this_grid();
  volatile LAS unsigned* bst = (volatile LAS unsigned*)(lds + LDS_BYTES - 16);
  if (threadIdx.x == 0) { bst[0] = 0u; bst[1] = 0u; (void)xb_add((unsigned*)(p0.ws + WS_BAR) + XB_XCNT(xb_xcc_id()), 1u); }
  __syncthreads();
  const int wave_s = __builtin_amdgcn_readfirstlane((int)threadIdx.x >> 6);
  for (int ph = p0.ph_lo; ph < p0.ph_hi; ++ph) {
   const int reps = ((REP_MASK >> (ph == 0 ? 7 : (ph - 1) % 7)) & 1) ? 2 : 1;
   for (int rep = 0; rep < reps; ++rep) {
    const bool dry = rep + 1 < reps;
    __builtin_amdgcn_s_waitcnt(0);
    const Params& p = p0;
    int lane_; asm volatile("v_mbcnt_lo_u32_b32 %0, -1, 0\n\tv_mbcnt_hi_u32_b32 %0, -1, %0" : "=v"(lane_));
    int tid = wave_s * 64 + lane_, bx = blockIdx.x, G = gridDim.x;
    unsigned char* ws = p0.ws; float* out = p0.out; asm volatile("" : "+v"(tid), "+s"(bx), "+s"(G));
    float* ssq = (float*)(ws + WS_SSQ); bf16_t* XB = (bf16_t*)(ws + WS_XB);
    if (ph == 0) phase_prep(tid, bx, G, lds, p, ws, out);
    else {
      const int l = (ph - 1) / 7, s = (ph - 1) % 7;
      if (s == 0) {
        pg8::Gemm g{XB, XB, (const bf16_t*)(ws + WS_WIN + l * SZ_WIN), (const bf16_t*)(ws + WS_WIN + l * SZ_WIN), DM};
        pg8::Order S; S.init(T_ALL, DIN, G, bx, 0);
        Epi1 E{(bf16_t*)(ws + WS_U), (bf16_t*)(ws + WS_GY), (bf16_t*)(ws + WS_Q), (bf16_t*)(ws + WS_K), (bf16_t*)(ws + WS_V), (bf16_t*)(ws + WS_GATES), ssq, p.in[9], p.in[17], p.in[18], out, l};
        pg8::gemm_phase<Epi1>(tid, lds, g, S, E);
        { const int nwg = (T_ALL / 256) * (DIN / 256), busy = nwg - ((nwg - 1) / G) * G;
          if (bx >= busy) { const int k = bx - busy, nid = G - busy, cnt = k < 2336 ? (2336 - k + nid - 1) / nid : 0; tr_range(tid, lds, p, ws, 1, l, k, cnt, nid); } }
      } else if (s == 1) {
        phase_mixers(tid, bx, G, lds, p, ws, out, l, dry);
      } else if (s == 2) {
        pg8::Gemm g{(const bf16_t*)(ws + WS_GY), (const bf16_t*)(ws + WS_Q), (const bf16_t*)(ws + WS_WBR + (size_t)(2 * l) * SZ_WSQ), (const bf16_t*)(ws + WS_WBR + (size_t)(2 * l + 1) * SZ_WSQ), DM};
        for (int t = bx; t < 256; t += G) small_gemm<0>(tid, lds, t, g.A0, g.B0, g.A1, g.B1, DM, (bf16_t*)(ws + WS_MIX), (const bf16_t*)(ws + WS_GATES), nullptr, nullptr, nullptr, dry, false);
        pg8::Order S; S.init(T_P, DM, G, bx, 1);
        EpiBr E{(bf16_t*)(ws + WS_MIX), (const bf16_t*)(ws + WS_GATES)};
        pg8::gemm_phase<EpiBr>(tid, lds, g, S, E);
      } else if (s == 3 || s == 6) {
        const bf16_t* A = s == 3 ? (const bf16_t*)(ws + WS_MIX) : (const bf16_t*)(ws + WS_UP);
        const bf16_t* B = s == 3 ? (const bf16_t*)(ws + WS_WOUT + l * SZ_WSQ) : (const bf16_t*)(ws + WS_WDN + l * SZ_WDN);
        pg8::Gemm g{A, A, B, B, s == 3 ? DM : DFF};
        for (int t = bx; t < 256; t += G) small_gemm<1>(tid, lds, t, A, B, A, B, s == 3 ? DM : DFF, nullptr, nullptr, out, XB, ssq, dry, l == 3 && s == 6);
        pg8::Order S; S.init(T_P, DM, G, bx, 0);
        EpiRes E{out, XB, ssq, dry, l == 3 && s == 6};
        pg8::gemm_phase<EpiRes>(tid, lds, g, S, E);
      } else if (s == 4) {
        pg8::Gemm g{XB, XB, (const bf16_t*)(ws + WS_WUP + l * SZ_WUP), (const bf16_t*)(ws + WS_WUP + l * SZ_WUP), DM};
        pg8::Order S; S.init(T_ALL, 2 * DFF, G, bx, 0);
        EpiUp E{(bf16_t*)(ws + WS_UP), (float*)(ws + WS_H), (float*)(ws + WS_G0), (float*)(ws + WS_U0), ssq, p.in[25], p.in[26], out, l};
        pg8::gemm_phase<EpiUp>(tid, lds, g, S, E);
        { const int nwg = (T_ALL / 256) * (2 * DFF / 256), busy = nwg - ((nwg - 1) / G) * G, ntile = l < 3 ? 2176 : 768;
          if (bx >= busy) { const int k = bx - busy, nid = G - busy, cnt = k < ntile ? (ntile - k + nid - 1) / nid : 0; tr_range(tid, lds, p, ws, 2, l, k, cnt, nid); } }
      } else {
        phase_ffnfix(tid, bx, G, p, ws, l, dry);
      }
    }
    if (dry) xcd_barrier(tid, (unsigned*)(ws + WS_BAR), bst, (unsigned)G);
   }
   if (ph + 1 < p0.ph_hi) {
     if (ph == 0 && (gridDim.x & 7u) != 0u) grid.sync();
     else { int t2 = wave_s * 64; { int l2; asm volatile("v_mbcnt_lo_u32_b32 %0, -1, 0\n\tv_mbcnt_hi_u32_b32 %0, -1, %0" : "=v"(l2)); t2 += l2; }
       xcd_barrier(t2, (unsigned*)(p0.ws + WS_BAR), bst, gridDim.x); }
   }
  }
}

extern "C" void kernel_launch(void* const* d_in, const int* in_sizes, int n_in, void* d_out, int out_size, void* d_ws, size_t ws_size, hipStream_t stream) {
  static int grid = 0;
  if (grid == 0) {
    if (n_in != 28 || ws_size < WS_END) { fprintf(stderr, "kernel_launch: need 28 inputs and %zu bytes of workspace, got %d / %zu\n", (size_t)WS_END, n_in, ws_size); grid = -1; return; }
    int dev = 0, cus = 0, per_cu = 0;
    hipGetDevice(&dev); hipDeviceGetAttribute(&cus, hipDeviceAttributeMultiprocessorCount, dev);
    if (hipFuncSetAttribute((const void*)mk_fwd, hipFuncAttributeMaxDynamicSharedMemorySize, LDS_BYTES) != hipSuccess) { fprintf(stderr, "kernel_launch: hipFuncSetAttribute failed\n"); grid = -1; return; }
    hipOccupancyMaxActiveBlocksPerMultiprocessor(&per_cu, (const void*)mk_fwd, 512, LDS_BYTES);
    (void)hipGetLastError();
    if (per_cu < 1) per_cu = 1;
    grid = cus * per_cu;
    if (grid > 256) grid = 256;
  }
  if (grid < 0) return;
  Params p{};
  for (int i = 0; i < 28; ++i) p.in[i] = (const float*)d_in[i];
  p.out = (float*)d_out; p.ws = (unsigned char*)d_ws;
#if MK_ONE_LAUNCH
  hipMemsetAsync((char*)d_ws + WS_BAR, 0, 16384, stream);
  p.ph_lo = 0; p.ph_hi = N_PHASES;
  void* args[] = {&p};
  hipError_t e = hipLaunchCooperativeKernel((const void*)mk_fwd, dim3(grid), dim3(512), args, LDS_BYTES, stream);
  if (e != hipSuccess) fprintf(stderr, "cooperative launch failed: %s (grid %d)\n", hipGetErrorString(e), grid);
#else
  for (int ph = 0; ph < N_PHASES; ++ph) {
    p.ph_lo = ph; p.ph_hi = ph + 1;
    hipLaunchKernelGGL(mk_fwd, dim3(grid), dim3(512), LDS_BYTES, stream, p);
  }
#endif
}
```

```cpp
#include <hip/hip_runtime.h>
#include <hip/hip_cooperative_groups.h>
#include <cstdio>
namespace cg = cooperative_groups;

#ifndef MK_ONE_LAUNCH
#define MK_ONE_LAUNCH 1
#endif

#ifndef STAGGER
#define STAGGER 0
#endif
#ifndef PG8_SP2
#define PG8_SP2 1
#endif
#ifndef REP_MASK
#define REP_MASK 0
#endif

#define LAS __attribute__((address_space(3)))
#define DI __device__ __forceinline__
typedef unsigned short bf16_t;
typedef short bf16x8 __attribute__((ext_vector_type(8)));
typedef float f32x4 __attribute__((ext_vector_type(4)));
typedef float f32x16 __attribute__((ext_vector_type(16)));
typedef float f32x2 __attribute__((ext_vector_type(2)));
typedef __bf16 bf2_t __attribute__((ext_vector_type(2)));
typedef unsigned u32x4 __attribute__((ext_vector_type(4)));
typedef unsigned u32x2 __attribute__((ext_vector_type(2)));

constexpr int T_P = 32768, T_S = 1024, T_ALL = T_P + T_S;
constexpr int DM = 1024, DIN = 5632, DFF = 3072;
constexpr float EPS = 1e-6f;
constexpr float LOG2E = 1.4426950408889634f;

constexpr size_t OUT_PLC = 34603008, OUT_PLH = 34799616, OUT_PK = 34865152, OUT_PV = 36962304, OUT_PFC = 39059456,
                 OUT_SLC = 39452672, OUT_SLH = 39845888, OUT_SK = 39976960, OUT_SV = 41025536, OUT_SFC = 42074112;

constexpr size_t SZ_WIN = (size_t)DIN * DM * 2, SZ_WSQ = (size_t)DM * DM * 2, SZ_WUP = (size_t)2 * DFF * DM * 2, SZ_WDN = (size_t)DM * DFF * 2, SZ_WBD = 16 * 64 * 64 * 2;
constexpr size_t WS_WIN = 0;
constexpr size_t WS_WBR = WS_WIN + 4 * SZ_WIN;
constexpr size_t WS_WOUT = WS_WBR + 8 * SZ_WSQ;
constexpr size_t WS_WUP = WS_WOUT + 4 * SZ_WSQ;
constexpr size_t WS_WDN = WS_WUP + 4 * SZ_WUP;
constexpr size_t WS_WA = WS_WDN + 4 * SZ_WDN;
constexpr size_t WS_WI = WS_WA + 4 * SZ_WBD;
constexpr size_t WS_XB = WS_WI + 4 * SZ_WBD;
constexpr size_t SLOT = (size_t)T_ALL * DM * 2;
constexpr size_t WS_SSQ = WS_XB + SLOT;
constexpr size_t WS_ST = WS_SSQ + (size_t)T_ALL * 16 * 4;
constexpr size_t WS_U = WS_ST, WS_GY = WS_ST + SLOT, WS_Q = WS_ST + 2 * SLOT, WS_GATES = WS_ST + 3 * SLOT, WS_K = WS_ST + 5 * SLOT, WS_V = WS_K + (size_t)T_ALL * 256 * 2;
constexpr size_t WS_MIX = WS_U;
constexpr size_t WS_GP = WS_ST, WS_UP = WS_ST + 3 * SLOT;
constexpr size_t WS_H = WS_ST, WS_G0 = WS_ST + (16u << 20), WS_U0 = WS_ST + (48u << 20);
constexpr size_t WS_BAR = WS_ST + 6 * SLOT;
constexpr size_t WS_END = WS_BAR + 16384;

struct Params {
  const float* in[28];
  float* out;
  unsigned char* ws;
  int ph_lo, ph_hi;
};

DI unsigned pk2(float lo, float hi) { f32x2 v = {lo, hi}; bf2_t r = __builtin_convertvector(v, bf2_t); return __builtin_bit_cast(unsigned, r); }
DI float bf2f(unsigned short h) { return __uint_as_float(((unsigned)h) << 16); }
DI float bflo(unsigned w) { return __uint_as_float(w << 16); }
DI float bfhi(unsigned w) { return __uint_as_float(w & 0xffff0000u); }
DI float sigmoidf_(float x) { return __builtin_amdgcn_rcpf(1.0f + __builtin_amdgcn_exp2f(-x * LOG2E)); }
DI float gelu_tanh(float x) {
  const float u = x * (1.0f + 0.044715f * x * x) * (1.5957691216057308f * LOG2E);
  return x * __builtin_amdgcn_rcpf(1.0f + __builtin_amdgcn_exp2f(-u));
}
DI u32x4 pack8(const float* v) { u32x4 w; w.x = pk2(v[0], v[1]); w.y = pk2(v[2], v[3]); w.z = pk2(v[4], v[5]); w.w = pk2(v[6], v[7]); return w; }

namespace pg8 {
constexpr int BM = 256, BK = 64, HALF = 128, HTB = HALF * BK * 2, STAGE_BYTES = 8 * HTB, NXCD = 8, WGM = 8;
DI int lds_byte(int r, int c) { const int st = (r >> 4) * 2 + (c >> 5), rr = r & 15, cc = c & 31, ob = rr * 64 + cc * 2; return st * 1024 + (ob ^ (((ob >> 9) & 1) << 5)); }
DI void stage_rc(int b, int& R, int& C) { const int st = b / 1024, sb = b % 1024, swz = sb ^ (((sb >> 9) & 1) << 5); R = (st >> 1) * 16 + swz / 64; C = (st & 1) * 32 + (swz % 64) / 2; }
DI int perm32(int rho) { const int n = rho >> 4, i = rho & 15; return 8 * (i >> 2) + 4 * n + (i & 3); }

struct Unit { int pm, pn, z; };
struct Gemm { const bf16_t *A0, *A1, *B0, *B1; int K; };

struct Order {
  int nM, nN, nwg, G, c, pair;
  DI void init(int M, int N, int G_, int c_, int pair_) { nM = M / BM; nN = N / BM; nwg = nM * nN; G = G_; c = c_; pair = pair_; }
  DI bool next(int i, Unit& u) const {
    const int ii = pair ? (i >> 1) : i;
    const long L = (long)ii * G + c; if (L >= nwg) return false;
    int wgid = (int)L; { const int q = nwg / NXCD, r = nwg % NXCD, xcd = wgid % NXCD, off = wgid / NXCD; wgid = (xcd < r ? xcd * (q + 1) : r * (q + 1) + (xcd - r) * q) + off; }
    const int nig = WGM * nN, gid = wgid / nig, fm = gid * WGM, gsz = (nM - fm) < WGM ? (nM - fm) : WGM;
    u.pm = fm + ((wgid % nig) % gsz); u.pn = (wgid % nig) / gsz; u.z = pair ? (i & 1) : 0; return true;
  }
};

template <class Epi>
DI void gemm_phase(const int tid_in, LAS unsigned char* lds, const Gemm g, const Order& S, const Epi& E) {
  int tid = tid_in; asm volatile("" : "+v"(tid));
  const int wid = __builtin_amdgcn_readfirstlane(tid >> 6), lane = tid & 63, wr = wid >> 2, wc = wid & 3, fr = lane & 15, fq = lane >> 4;
  const int K = g.K, nt = K / BK;
  unsigned voffA[2], voffB[2];
#pragma unroll
  for (int i = 0; i < 2; ++i) { int R, C; stage_rc(tid * 16 + i * 8192, R, C); const int Rb = (R & ~31) + perm32(R & 31);
    voffA[i] = (unsigned)(R * K + C) * 2u; voffB[i] = (unsigned)(Rb * K + C) * 2u; }
  const size_t kstep = (size_t)(BK * 2);
  const size_t hstep = (size_t)HALF * K * 2;
  const size_t tstep = 2 * hstep;
  const unsigned ldsw = (unsigned)wid * 1024u;
  const int aoff = lds_byte(wr * 64 + fr, fq * 8), boff = lds_byte(wc * 32 + fr, fq * 8);
#define PG8_SA(b, h) (((b) * 2 + (h)) * HTB)
#define PG8_SB(b, h) ((4 + (b) * 2 + (h)) * HTB)
#define PG8_STAGE(bufoff, gbase, voff) do { _Pragma("unroll") for (int _i = 0; _i < 2; ++_i) \
    asm volatile("s_mov_b32 m0, %2\n\ts_nop 0\n\tglobal_load_lds_dwordx4 %0, %1" :: "v"((voff)[_i]), "s"((const char*)(gbase)), "s"((unsigned)(size_t)(lds + (bufoff) + ldsw + _i * 8192)) : "memory", "m0"); } while (0)
#define PG8_LDA(dst, b, h) do { _Pragma("unroll") for (int m = 0; m < 4; ++m) _Pragma("unroll") for (int k = 0; k < 2; ++k) dst[m][k] = *(const LAS bf16x8*)(lds + PG8_SA(b, h) + aoff + m * 2048 + k * 1024); } while (0)
#define PG8_LDB(dst, b, h) do { _Pragma("unroll") for (int n = 0; n < 2; ++n) _Pragma("unroll") for (int k = 0; k < 2; ++k) dst[n][k] = *(const LAS bf16x8*)(lds + PG8_SB(b, h) + boff + n * 2048 + k * 1024); } while (0)
#define PG8_MMA(ai, bj, At, Bt) do { __builtin_amdgcn_s_setprio(1); _Pragma("unroll") for (int m = 0; m < 4; ++m) _Pragma("unroll") for (int n = 0; n < 2; ++n) _Pragma("unroll") for (int k = 0; k < 2; ++k) \
    acc[ai][bj][m][n] = __builtin_amdgcn_mfma_f32_16x16x32_bf16(Bt[n][k], At[m][k], acc[ai][bj][m][n], 0, 0, 0); __builtin_amdgcn_s_setprio(0); } while (0)
#define PG8_WAIT_V(n) asm volatile("s_waitcnt vmcnt(" #n ")" ::: "memory")
#define PG8_WAIT_L(n) asm volatile("s_waitcnt lgkmcnt(" #n ")" ::: "memory")
#define PG8_BAR __builtin_amdgcn_s_barrier()
#define PG8_SCHED __builtin_amdgcn_sched_barrier(0)
  Unit cur, nxt; int ui = 0;
  if (!S.next(0, cur)) return;
  if constexpr (Epi::HAS_RS) {
    LAS float* rsl = (LAS float*)(lds + STAGE_BYTES);
    LAS int* pml = (LAS int*)(lds + STAGE_BYTES + 14 * 1024);
    { Unit u2;
#pragma unroll 1
      for (int i = 0; i < 14; ++i) { const bool ok = S.next(i, u2); if (tid == 0) pml[i] = ok ? u2.pm : -1; } }
    __syncthreads();
#pragma unroll 1
    for (int i0 = 0; i0 < 14; i0 += 7) {
      f32x4 pa[7], pb[7]; int pmv[7];
#pragma unroll
      for (int j = 0; j < 7; ++j) { pmv[j] = pml[i0 + j]; pa[j] = (f32x4){0.f, 0.f, 0.f, 0.f}; pb[j] = pa[j];
        if (pmv[j] >= 0) { const float* sp = E.ssq + (size_t)(pmv[j] * 256 + (tid >> 1)) * 16 + (tid & 1) * 8; pa[j] = *(const f32x4*)sp; pb[j] = *(const f32x4*)(sp + 4); } }
#pragma unroll
      for (int j = 0; j < 7; ++j) { float s = pa[j].x + pa[j].y + pa[j].z + pa[j].w + pb[j].x + pb[j].y + pb[j].z + pb[j].w; s += __shfl_xor(s, 1);
        if (pmv[j] >= 0 && (tid & 1) == 0) rsl[(i0 + j) * 256 + (tid >> 1)] = rsqrtf(s * (1.0f / 1024.0f) + EPS); }
    }
    __syncthreads();
  }
  f32x4 acc[2][2][4][2];
#pragma unroll
  for (int a = 0; a < 2; ++a)
#pragma unroll
    for (int b = 0; b < 2; ++b)
#pragma unroll
      for (int m = 0; m < 4; ++m)
#pragma unroll
        for (int n = 0; n < 2; ++n) acc[a][b][m][n] = (f32x4){0.f, 0.f, 0.f, 0.f};
  bf16x8 At[4][2], B0[2][2], B1[2][2];
  const char* cA = (const char*)(cur.z ? g.A1 : g.A0) + (size_t)cur.pm * tstep; const char* cB = (const char*)(cur.z ? g.B1 : g.B0) + (size_t)cur.pn * tstep;
#if PG8_SP2
  PG8_STAGE(PG8_SB(0, 0), cB, voffB); PG8_STAGE(PG8_SB(0, 1), cB + hstep, voffB); PG8_STAGE(PG8_SA(0, 0), cA, voffA); PG8_STAGE(PG8_SA(0, 1), cA + hstep, voffA);
  if (wr == 1) PG8_BAR;
  PG8_WAIT_V(2); PG8_BAR;
  PG8_STAGE(PG8_SB(1, 0), cB + kstep, voffB); PG8_STAGE(PG8_SA(1, 0), cA + kstep, voffA); PG8_STAGE(PG8_SB(1, 1), cB + hstep + kstep, voffB);
  PG8_WAIT_V(6); PG8_BAR;
#else
  PG8_STAGE(PG8_SB(0, 0), cB, voffB); PG8_STAGE(PG8_SA(0, 0), cA, voffA); PG8_STAGE(PG8_SB(0, 1), cB + hstep, voffB); PG8_STAGE(PG8_SA(0, 1), cA + hstep, voffA);
  if (wr == 1) PG8_BAR;
  PG8_WAIT_V(4); PG8_BAR;
  PG8_STAGE(PG8_SB(1, 0), cB + kstep, voffB); PG8_STAGE(PG8_SA(1, 0), cA + kstep, voffA); PG8_STAGE(PG8_SB(1, 1), cB + hstep + kstep, voffB);
  PG8_WAIT_V(6); PG8_BAR;
#endif
  for (;;) {
    const bool has_next = S.next(ui + 1, nxt);
    const char* nA = has_next ? (const char*)(nxt.z ? g.A1 : g.A0) + (size_t)nxt.pm * tstep : cA; const char* nB = has_next ? (const char*)(nxt.z ? g.B1 : g.B0) + (size_t)nxt.pn * tstep : cB;
    for (int t = 0; t < nt; t += 2) {
      const bool last = (t == nt - 2);
      const char* a1 = cA + (size_t)(t + 1) * kstep;
      const char* a2 = last ? nA : cA + (size_t)(t + 2) * kstep; const char* b2 = last ? nB : cB + (size_t)(t + 2) * kstep;
      const char* a3 = a2 + kstep; const char* b3 = b2 + kstep;
#if PG8_SP2
      PG8_LDB(B0, 0, 0); PG8_LDB(B1, 0, 1); PG8_SCHED; PG8_LDA(At, 0, 0); PG8_STAGE(PG8_SA(1, 1), a1 + hstep, voffA);
      PG8_WAIT_V(8); PG8_WAIT_L(0); PG8_BAR; PG8_MMA(0, 0, At, B0); PG8_MMA(0, 1, At, B1); PG8_BAR; PG8_SCHED;
      PG8_LDA(At, 0, 1); PG8_STAGE(PG8_SB(0, 0), b2, voffB); PG8_STAGE(PG8_SB(0, 1), b2 + hstep, voffB); PG8_STAGE(PG8_SA(0, 0), a2, voffA);
      PG8_WAIT_V(8); PG8_WAIT_L(0); PG8_BAR; PG8_MMA(1, 0, At, B0); PG8_MMA(1, 1, At, B1); PG8_BAR; PG8_SCHED;
      PG8_LDB(B0, 1, 0); PG8_LDB(B1, 1, 1); PG8_SCHED; PG8_LDA(At, 1, 0); PG8_STAGE(PG8_SA(0, 1), a2 + hstep, voffA);
      PG8_WAIT_V(8); PG8_WAIT_L(0); PG8_BAR; PG8_MMA(0, 0, At, B0); PG8_MMA(0, 1, At, B1); PG8_BAR; PG8_SCHED;
      PG8_LDA(At, 1, 1); PG8_STAGE(PG8_SB(1, 0), b3, voffB); PG8_STAGE(PG8_SB(1, 1), b3 + hstep, voffB); PG8_STAGE(PG8_SA(1, 0), a3, voffA);
      PG8_WAIT_V(8); PG8_WAIT_L(0); PG8_BAR; PG8_MMA(1, 0, At, B0); PG8_MMA(1, 1, At, B1); PG8_BAR; PG8_SCHED;
#else
      PG8_LDB(B0, 0, 0); PG8_SCHED; PG8_LDA(At, 0, 0); PG8_STAGE(PG8_SA(1, 1), a1 + hstep, voffA);
      PG8_WAIT_L(8); PG8_BAR; PG8_WAIT_L(0); PG8_MMA(0, 0, At, B0); PG8_BAR; PG8_SCHED;
      PG8_LDB(B1, 0, 1); PG8_STAGE(PG8_SB(0, 0), b2, voffB);
      PG8_BAR; PG8_WAIT_L(0); PG8_MMA(0, 1, At, B1); PG8_BAR;
      PG8_LDA(At, 0, 1); PG8_STAGE(PG8_SA(0, 0), a2, voffA);
      PG8_BAR; PG8_WAIT_L(0); PG8_MMA(1, 0, At, B0); PG8_BAR; PG8_SCHED;
      PG8_STAGE(PG8_SB(0, 1), b2 + hstep, voffB);
      PG8_WAIT_V(6); PG8_BAR; PG8_MMA(1, 1, At, B1); PG8_BAR;
      PG8_LDB(B0, 1, 0); PG8_SCHED; PG8_LDA(At, 1, 0); PG8_STAGE(PG8_SA(0, 1), a2 + hstep, voffA);
      PG8_WAIT_L(8); PG8_BAR; PG8_WAIT_L(0); PG8_MMA(0, 0, At, B0); PG8_BAR; PG8_SCHED;
      PG8_LDB(B1, 1, 1); PG8_STAGE(PG8_SB(1, 0), b3, voffB);
      PG8_BAR; PG8_WAIT_L(0); PG8_MMA(0, 1, At, B1); PG8_BAR;
      PG8_LDA(At, 1, 1); PG8_STAGE(PG8_SA(1, 0), a3, voffA);
      PG8_BAR; PG8_WAIT_L(0); PG8_MMA(1, 0, At, B0); PG8_BAR; PG8_SCHED;
      PG8_STAGE(PG8_SB(1, 1), b3 + hstep, voffB);
      PG8_WAIT_V(6); PG8_BAR; PG8_MMA(1, 1, At, B1); PG8_BAR;
#endif
    }
    if (wr == 0) PG8_BAR;
    { int fr2 = fr, fq2 = fq; asm volatile("" : "+v"(fr2), "+v"(fq2)); E(acc, cur, wr, wc, fr2, fq2, (const LAS float*)(lds + STAGE_BYTES) + ui * 256); }
    if (!has_next) break;
#pragma unroll
    for (int a = 0; a < 2; ++a)
#pragma unroll
      for (int b = 0; b < 2; ++b)
#pragma unroll
        for (int m = 0; m < 4; ++m)
#pragma unroll
          for (int n = 0; n < 2; ++n) acc[a][b][m][n] = (f32x4){0.f, 0.f, 0.f, 0.f};
    cur = nxt; cA = nA; cB = nB; ++ui;
    if (wr == 1) PG8_BAR;
  }
  PG8_WAIT_V(0);
  PG8_BAR;
#undef PG8_SA
#undef PG8_SB
#undef PG8_STAGE
#undef PG8_LDA
#undef PG8_LDB
#undef PG8_MMA
#undef PG8_WAIT_V
#undef PG8_WAIT_L
#undef PG8_BAR
#undef PG8_SCHED
}
}
using pg8::Unit;
typedef f32x4 AccT[2][2][4][2];

DI float row_rs(const float* ssq, int row, int fq) {
  const f32x4 pp = *(const f32x4*)(ssq + (size_t)row * 16 + 4 * fq);
  float s = pp.x + pp.y + pp.z + pp.w; s += __shfl_xor(s, 16); s += __shfl_xor(s, 32);
  return rsqrtf(s * (1.0f / 1024.0f) + EPS);
}

struct Epi1 {
  static constexpr bool DRAIN = true, HAS_RS = true;
  bf16_t *U, *GY, *Q, *Kb, *Vb, *GATES; const float* ssq; const float *b_gate, *g_q, *g_k; float* out; int l;
  template <int REG> DI void body(const AccT& acc, const Unit& u, int wr, int wc, int fr, int fq, const LAS float* rsl) const {
    const int pn = u.pn;
#pragma unroll
    for (int ai = 0; ai < 2; ++ai) {
      float rsv[4];
#pragma unroll
      for (int m = 0; m < 4; ++m) rsv[m] = rsl[ai * 128 + wr * 64 + m * 16 + fr];
      __builtin_amdgcn_sched_barrier(0);
#pragma unroll
      for (int m = 0; m < 4; ++m) {
        const int row = u.pm * 256 + ai * 128 + wr * 64 + m * 16 + fr;
        const float rs = rsv[m];
        float v[2][8];
#pragma unroll
        for (int bj = 0; bj < 2; ++bj)
#pragma unroll
          for (int n = 0; n < 2; ++n)
#pragma unroll
            for (int j = 0; j < 4; ++j) v[bj][4 * n + j] = acc[ai][bj][m][n][j] * rs;
        const bool isp = row < T_P; const int rp = row - T_P;
        const int b = isp ? (row >> 11) : (rp >> 5), t = isp ? (row & 2047) : (rp & 31);
        if constexpr (REG == 0) {
          int ooff = -1;
          if (isp) { if (t >= 2045) ooff = (int)OUT_PLC + ((l * 16 + b) * 3 + (t - 2045)) * 1024; }
          else { if (t >= 29) ooff = (int)OUT_SLC + ((l * 32 + b) * 3 + (t - 29)) * 1024; }
#pragma unroll
          for (int bj = 0; bj < 2; ++bj) {
            const int col = pn * 256 + bj * 128 + wc * 32 + fq * 8;
            *(u32x4*)(U + (size_t)row * 1024 + col) = pack8(v[bj]);
            if (ooff >= 0) { float* o = out + ooff + col; *(f32x4*)o = (f32x4){v[bj][0], v[bj][1], v[bj][2], v[bj][3]}; *(f32x4*)(o + 4) = (f32x4){v[bj][4], v[bj][5], v[bj][6], v[bj][7]}; }
          }
        } else if constexpr (REG == 1) {
#pragma unroll
          for (int bj = 0; bj < 2; ++bj) {
            const int col = (pn - 4) * 256 + bj * 128 + wc * 32 + fq * 8;
            float w[8];
#pragma unroll
            for (int i = 0; i < 8; ++i) w[i] = gelu_tanh(v[bj][i]);
            *(u32x4*)(GY + (size_t)row * 1024 + col) = pack8(w);
          }
        } else if constexpr (REG == 2 || REG == 3) {
          float ss = 0.f;
#pragma unroll
          for (int bj = 0; bj < 2; ++bj)
#pragma unroll
            for (int i = 0; i < 8; ++i) ss += v[bj][i] * v[bj][i];
          ss += __shfl_xor(ss, 16); ss += __shfl_xor(ss, 32);
          const float sc = rsqrtf(ss * (1.0f / 64.0f) + EPS);
          int ooff = -1;
          if (REG == 3) { if (isp) { if (t >= 1920) ooff = (int)OUT_PK + ((l * 16 + b) * 128 + (t - 1920)) * 256; } else ooff = (int)OUT_SK + (l * 1024 + rp) * 256; }
#pragma unroll
          for (int bj = 0; bj < 2; ++bj) {
            const int d0 = 32 * bj + 8 * fq;
            const float* gg = (REG == 2 ? g_q : g_k) + l * 64;
            const f32x4 c0 = *(const f32x4*)(gg + d0), c1 = *(const f32x4*)(gg + d0 + 4);
            float w[8];
#pragma unroll
            for (int i = 0; i < 4; ++i) { w[i] = v[bj][i] * sc * c0[i]; w[4 + i] = v[bj][4 + i] * sc * c1[i]; }
            if (REG == 2) *(u32x4*)(Q + (size_t)row * 1024 + (pn - 8) * 256 + 64 * wc + d0) = pack8(w);
            else {
              *(u32x4*)(Kb + (size_t)row * 256 + 64 * wc + d0) = pack8(w);
              if (ooff >= 0) { float* o = out + ooff + 64 * wc + d0; *(f32x4*)o = (f32x4){w[0], w[1], w[2], w[3]}; *(f32x4*)(o + 4) = (f32x4){w[4], w[5], w[6], w[7]}; }
            }
          }
        } else if constexpr (REG == 4) {
          int ooff = -1;
          if (isp) { if (t >= 1920) ooff = (int)OUT_PV + ((l * 16 + b) * 128 + (t - 1920)) * 256; } else ooff = (int)OUT_SV + (l * 1024 + rp) * 256;
#pragma unroll
          for (int bj = 0; bj < 2; ++bj) {
            const int col = bj * 128 + wc * 32 + fq * 8;
            *(u32x4*)(Vb + (size_t)row * 256 + col) = pack8(v[bj]);
            if (ooff >= 0) { float* o = out + ooff + col; *(f32x4*)o = (f32x4){v[bj][0], v[bj][1], v[bj][2], v[bj][3]}; *(f32x4*)(o + 4) = (f32x4){v[bj][4], v[bj][5], v[bj][6], v[bj][7]}; }
          }
        } else {
#pragma unroll
          for (int bj = 0; bj < 2; ++bj) {
            const int col = (pn - 14) * 256 + bj * 128 + wc * 32 + fq * 8;
            const f32x4 c0 = *(const f32x4*)(b_gate + l * 2048 + col), c1 = *(const f32x4*)(b_gate + l * 2048 + col + 4);
            float w[8];
#pragma unroll
            for (int i = 0; i < 4; ++i) { w[i] = sigmoidf_(v[bj][i] + c0[i]); w[4 + i] = sigmoidf_(v[bj][4 + i] + c1[i]); }
            *(u32x4*)(GATES + (size_t)row * 2048 + col) = pack8(w);
          }
        }
        if (m & 1) __builtin_amdgcn_sched_barrier(0);
      }
    }
  }
  DI void operator()(const AccT& acc, const Unit& u, int wr, int wc, int fr, int fq, const LAS float* rsl) const {
    const int pn = u.pn;
    if (pn < 4) body<0>(acc, u, wr, wc, fr, fq, rsl);
    else if (pn < 8) body<1>(acc, u, wr, wc, fr, fq, rsl);
    else if (pn < 12) body<2>(acc, u, wr, wc, fr, fq, rsl);
    else if (pn == 12) body<3>(acc, u, wr, wc, fr, fq, rsl);
    else if (pn == 13) body<4>(acc, u, wr, wc, fr, fq, rsl);
    else body<5>(acc, u, wr, wc, fr, fq, rsl);
  }
};

struct EpiBr {
  static constexpr bool DRAIN = false, HAS_RS = false;
  bf16_t* MIX; const bf16_t* GATES;
  DI void operator()(const AccT& acc, const Unit& u, int wr, int wc, int fr, int fq, const LAS float*) const {
    const int z = u.z;
#pragma unroll
    for (int ai = 0; ai < 2; ++ai) {
      u32x4 gw[4][2], pw[4][2];
#pragma unroll
      for (int m = 0; m < 4; ++m)
#pragma unroll
        for (int bj = 0; bj < 2; ++bj) {
          const int row = u.pm * 256 + ai * 128 + wr * 64 + m * 16 + fr, col = u.pn * 256 + bj * 128 + wc * 32 + fq * 8;
          gw[m][bj] = *(const u32x4*)(GATES + (size_t)row * 2048 + z * 1024 + col);
          pw[m][bj] = (u32x4){0u, 0u, 0u, 0u};
          if (z) pw[m][bj] = *(const u32x4*)(MIX + (size_t)row * 1024 + col);
        }
      __builtin_amdgcn_sched_barrier(0);
#pragma unroll
      for (int m = 0; m < 4; ++m) {
#pragma unroll
        for (int bj = 0; bj < 2; ++bj) {
          const int row = u.pm * 256 + ai * 128 + wr * 64 + m * 16 + fr, col = u.pn * 256 + bj * 128 + wc * 32 + fq * 8;
          const u32x4 g4 = gw[m][bj], p4 = pw[m][bj];
          float w[8];
          w[0] = bflo(g4.x) * acc[ai][bj][m][0][0] + bflo(p4.x); w[1] = bfhi(g4.x) * acc[ai][bj][m][0][1] + bfhi(p4.x);
          w[2] = bflo(g4.y) * acc[ai][bj][m][0][2] + bflo(p4.y); w[3] = bfhi(g4.y) * acc[ai][bj][m][0][3] + bfhi(p4.y);
          w[4] = bflo(g4.z) * acc[ai][bj][m][1][0] + bflo(p4.z); w[5] = bfhi(g4.z) * acc[ai][bj][m][1][1] + bfhi(p4.z);
          w[6] = bflo(g4.w) * acc[ai][bj][m][1][2] + bflo(p4.w); w[7] = bfhi(g4.w) * acc[ai][bj][m][1][3] + bfhi(p4.w);
          *(u32x4*)(MIX + (size_t)row * 1024 + col) = pack8(w);
        }
        if (m & 1) __builtin_amdgcn_sched_barrier(0);
      }
    }
  }
};

struct EpiRes {
  static constexpr bool DRAIN = false, HAS_RS = false;
  float* X; bf16_t* XB; float* ssq; bool dry, fin;
  DI void operator()(const AccT& acc, const Unit& u, int wr, int wc, int fr, int fq, const LAS float*) const {
    u32x4 xv[2][4][2];
#pragma unroll
    for (int ai = 0; ai < 2; ++ai)
#pragma unroll
      for (int m = 0; m < 4; ++m)
#pragma unroll
        for (int bj = 0; bj < 2; ++bj)
          xv[ai][m][bj] = *(const u32x4*)(XB + (size_t)(u.pm * 256 + ai * 128 + wr * 64 + m * 16 + fr) * 1024 + u.pn * 256 + bj * 128 + wc * 32 + fq * 8);
    __builtin_amdgcn_sched_barrier(0);
#pragma unroll
    for (int ai = 0; ai < 2; ++ai)
#pragma unroll
      for (int m = 0; m < 4; ++m) {
        const int row = u.pm * 256 + ai * 128 + wr * 64 + m * 16 + fr;
        float ss = 0.f;
#pragma unroll
        for (int bj = 0; bj < 2; ++bj) {
          const int col = u.pn * 256 + bj * 128 + wc * 32 + fq * 8;
          const u32x4 x4 = xv[ai][m][bj];
          float w[8];
          w[0] = bflo(x4.x) + acc[ai][bj][m][0][0]; w[1] = bfhi(x4.x) + acc[ai][bj][m][0][1]; w[2] = bflo(x4.y) + acc[ai][bj][m][0][2]; w[3] = bfhi(x4.y) + acc[ai][bj][m][0][3];
          w[4] = bflo(x4.z) + acc[ai][bj][m][1][0]; w[5] = bfhi(x4.z) + acc[ai][bj][m][1][1]; w[6] = bflo(x4.w) + acc[ai][bj][m][1][2]; w[7] = bfhi(x4.w) + acc[ai][bj][m][1][3];
#pragma unroll
          for (int i = 0; i < 8; ++i) ss += w[i] * w[i];
          if (!dry) {
            if (fin) { float* xp = X + (size_t)row * 1024 + col; *(f32x4*)xp = (f32x4){w[0], w[1], w[2], w[3]}; *(f32x4*)(xp + 4) = (f32x4){w[4], w[5], w[6], w[7]}; }
            else *(u32x4*)(XB + (size_t)row * 1024 + col) = pack8(w);
          }
        }
        ss += __shfl_xor(ss, 16); ss += __shfl_xor(ss, 32);
        if (fq == 0 && (!dry || ss == -1.f)) ssq[(size_t)row * 16 + u.pn * 4 + wc] = ss;
        if (m & 1) __builtin_amdgcn_sched_barrier(0);
      }
  }
};

struct EpiUp {
  static constexpr bool DRAIN = false, HAS_RS = true;
  bf16_t* ACT; float *H, *G0, *U0; const float* ssq; const float *wf, *bfc; float* out; int l;
  DI void operator()(const AccT& acc, const Unit& u, int wr, int wc, int fr, int fq, const LAS float* rsl) const {
    const int pn = u.pn, colb = pn * 128 + wc * 32 + fq * 8;
    const bool isp = u.pm < 128;
    float rsv[2][4];
#pragma unroll
    for (int ai = 0; ai < 2; ++ai)
#pragma unroll
      for (int m = 0; m < 4; ++m) rsv[ai][m] = rsl[ai * 128 + wr * 64 + m * 16 + fr];
    float w0[8], w1[8], w2[8], bb[8];
    { const float* wp = wf + (size_t)l * 3 * 3072 + colb; const float* bp = bfc + l * 3072 + colb;
      const f32x4 a0 = *(const f32x4*)wp, a1 = *(const f32x4*)(wp + 4), b0 = *(const f32x4*)(wp + 3072), b1 = *(const f32x4*)(wp + 3076), c0 = *(const f32x4*)(wp + 6144), c1 = *(const f32x4*)(wp + 6148), d0 = *(const f32x4*)bp, d1 = *(const f32x4*)(bp + 4);
#pragma unroll
      for (int i = 0; i < 4; ++i) { w0[i] = a0[i]; w0[4 + i] = a1[i]; w1[i] = b0[i]; w1[4 + i] = b1[i]; w2[i] = c0[i]; w2[4 + i] = c1[i]; bb[i] = d0[i]; bb[4 + i] = d1[i]; }
#pragma unroll
      for (int i = 0; i < 8; ++i) asm volatile("" : "+v"(w0[i]), "+v"(w1[i]), "+v"(w2[i]), "+v"(bb[i])); }
    __builtin_amdgcn_s_waitcnt(0x0F70);
    __builtin_amdgcn_sched_barrier(0);
    const int lane = fr + 16 * fq, src1 = (lane & 48) | ((lane - 1) & 15), src2 = (lane & 48) | ((lane - 2) & 15);
#pragma unroll
    for (int ai = 0; ai < 2; ++ai) {
      float pA1[8], pA2[8];
#pragma unroll
      for (int i = 0; i < 8; ++i) { pA1[i] = 0.f; pA2[i] = 0.f; }
#pragma unroll
      for (int m = 0; m < 4; ++m) {
        const int row = u.pm * 256 + ai * 128 + wr * 64 + m * 16 + fr;
        const float rs = rsv[ai][m];
        float g[8], up[8], A1[8], A2[8];
#pragma unroll
        for (int i = 0; i < 4; ++i) { g[i] = acc[ai][0][m][0][i] * rs; g[4 + i] = acc[ai][0][m][1][i] * rs; up[i] = acc[ai][1][m][0][i] * rs; up[4 + i] = acc[ai][1][m][1][i] * rs; }
#pragma unroll
        for (int i = 0; i < 8; ++i) {
          A1[i] = __builtin_bit_cast(float, __builtin_amdgcn_update_dpp(0, __builtin_bit_cast(int, g[i]), 0x121, 0xf, 0xf, false));
          A2[i] = __builtin_bit_cast(float, __builtin_amdgcn_update_dpp(0, __builtin_bit_cast(int, g[i]), 0x122, 0xf, 0xf, false)); }
        const bool deferred = fr < 2 && (m == 0 || (!isp && m == 2));
        if (!deferred) {
          float o[8];
#pragma unroll
          for (int i = 0; i < 8; ++i) { const float p1 = fr >= 1 ? A1[i] : pA1[i], p2 = fr >= 2 ? A2[i] : pA2[i]; o[i] = gelu_tanh(bb[i] + w0[i] * p2 + w1[i] * p1 + w2[i] * g[i]) * up[i]; }
          *(u32x4*)(ACT + (size_t)row * 3072 + colb) = pack8(o);
        } else {
          const size_t so = ((size_t)(row >> 5) * 2 + (row & 1)) * 3072 + colb;
          *(f32x4*)(G0 + so) = (f32x4){g[0], g[1], g[2], g[3]}; *(f32x4*)(G0 + so + 4) = (f32x4){g[4], g[5], g[6], g[7]};
          *(f32x4*)(U0 + so) = (f32x4){up[0], up[1], up[2], up[3]}; *(f32x4*)(U0 + so + 4) = (f32x4){up[4], up[5], up[6], up[7]};
        }
        if (fr >= 14 && (m == 3 || (!isp && m == 1))) {
          if (m == 3) { const size_t ho = ((size_t)(row >> 6) * 2 + (fr - 14)) * 3072 + colb;
            *(f32x4*)(H + ho) = (f32x4){g[0], g[1], g[2], g[3]}; *(f32x4*)(H + ho + 4) = (f32x4){g[4], g[5], g[6], g[7]}; }
          int ooff = -1;
          if (isp) { const int t = row & 2047; if (t >= 2046) ooff = (int)OUT_PFC + ((l * 16 + (row >> 11)) * 2 + (t - 2046)) * 3072; }
          else { const int rp = row - T_P, t = rp & 31; if (t >= 30) ooff = (int)OUT_SFC + ((l * 32 + (rp >> 5)) * 2 + (t - 30)) * 3072; }
          if (ooff >= 0) { float* o = out + ooff + colb; *(f32x4*)o = (f32x4){g[0], g[1], g[2], g[3]}; *(f32x4*)(o + 4) = (f32x4){g[4], g[5], g[6], g[7]}; }
        }
#pragma unroll
        for (int i = 0; i < 8; ++i) { pA1[i] = A1[i]; pA2[i] = A2[i]; }
        __builtin_amdgcn_sched_barrier(0);
      }
    }
  }
};

DI void sg_partial(const int tid, LAS float* red, const bf16_t* A, const bf16_t* B, const int K, const int row0, const int col0, f32x4 (&res)[2]) {
  const int wave = tid >> 6, lane = tid & 63, r = lane & 15, kq = lane >> 4;
  const int KW = K >> 3;
  f32x4 acc[4][4];
#pragma unroll
  for (int rb = 0; rb < 4; ++rb)
#pragma unroll
    for (int cb = 0; cb < 4; ++cb) acc[rb][cb] = (f32x4){0.f, 0.f, 0.f, 0.f};
  const bf16_t* ap = A + (size_t)(row0 + r) * K + wave * KW + 8 * kq;
  const bf16_t* bp = B + (size_t)(col0 + r) * K + wave * KW + 8 * kq;
#pragma unroll 1
  for (int k = 0; k < KW; k += 128) {
    bf16x8 af[4][4], bfr[4][4];
#pragma unroll
    for (int s = 0; s < 4; ++s)
#pragma unroll
      for (int q = 0; q < 4; ++q) { af[s][q] = *(const bf16x8*)(ap + (size_t)q * 16 * K + k + 32 * s); bfr[s][q] = *(const bf16x8*)(bp + (size_t)q * 16 * K + k + 32 * s); }
#pragma unroll
    for (int s = 0; s < 4; ++s)
#pragma unroll
      for (int rb = 0; rb < 4; ++rb)
#pragma unroll
        for (int cb = 0; cb < 4; ++cb) acc[rb][cb] = __builtin_amdgcn_mfma_f32_16x16x32_bf16(bfr[s][cb], af[s][rb], acc[rb][cb], 0, 0, 0);
  }
  __syncthreads();
#pragma unroll
  for (int rb = 0; rb < 4; ++rb)
#pragma unroll
    for (int cb = 0; cb < 4; ++cb) *(LAS f32x4*)(red + ((wave * 16 + rb * 4 + cb) * 64 + lane) * 4) = acc[rb][cb];
  __syncthreads();
#pragma unroll
  for (int h = 0; h < 2; ++h) {
    const int blk = (wave >> 1) * 4 + 2 * (wave & 1) + h;
    f32x4 s = *(const LAS f32x4*)(red + ((0 * 16 + blk) * 64 + lane) * 4);
#pragma unroll
    for (int w2 = 1; w2 < 8; ++w2) s += *(const LAS f32x4*)(red + ((w2 * 16 + blk) * 64 + lane) * 4);
    res[h] = s;
  }
}
template <int MODE>
DI void small_gemm(const int tid, LAS unsigned char* lds, const int tile, const bf16_t* A0, const bf16_t* B0, const bf16_t* A1, const bf16_t* B1, const int K,
                   bf16_t* MIX, const bf16_t* GATES, float* X, bf16_t* XB, float* ssq, const bool dry, const bool fin) {
  const int wave = tid >> 6, lane = tid & 63, r = lane & 15, kq = lane >> 4;
  const int tm = tile >> 4, tn = tile & 15, row0 = T_P + tm * 64, col0 = tn * 64;
  LAS float* red = (LAS float*)lds;
  LAS float* ssp = (LAS float*)(lds + 131072);
  const int row = row0 + 16 * (wave >> 1) + r;
  f32x4 c0[2];
  sg_partial(tid, red, A0, B0, K, row0, col0, c0);
  if constexpr (MODE == 0) {
    f32x4 c1[2];
    sg_partial(tid, red, A1, B1, K, row0, col0, c1);
#pragma unroll
    for (int h = 0; h < 2; ++h) {
      const int col = col0 + 16 * (2 * (wave & 1) + h) + 4 * kq;
      const u32x2 g0 = *(const u32x2*)(GATES + (size_t)row * 2048 + col), g1 = *(const u32x2*)(GATES + (size_t)row * 2048 + 1024 + col);
      u32x2 w;
      w.x = pk2(bflo(g0.x) * c0[h][0] + bflo(g1.x) * c1[h][0], bfhi(g0.x) * c0[h][1] + bfhi(g1.x) * c1[h][1]);
      w.y = pk2(bflo(g0.y) * c0[h][2] + bflo(g1.y) * c1[h][2], bfhi(g0.y) * c0[h][3] + bfhi(g1.y) * c1[h][3]);
      *(u32x2*)(MIX + (size_t)row * 1024 + col) = w;
    }
  } else {
    float ss = 0.f;
#pragma unroll
    for (int h = 0; h < 2; ++h) {
      const int col = col0 + 16 * (2 * (wave & 1) + h) + 4 * kq;
      const u32x2 xb2 = *(const u32x2*)(XB + (size_t)row * 1024 + col);
      const f32x4 w = (f32x4){bflo(xb2.x), bfhi(xb2.x), bflo(xb2.y), bfhi(xb2.y)} + c0[h];
      ss += w[0] * w[0] + w[1] * w[1] + w[2] * w[2] + w[3] * w[3];
      if (!dry) { if (fin) *(f32x4*)(X + (size_t)row * 1024 + col) = w; else { u32x2 wb; wb.x = pk2(w[0], w[1]); wb.y = pk2(w[2], w[3]); *(u32x2*)(XB + (size_t)row * 1024 + col) = wb; } }
    }
    ss += __shfl_xor(ss, 16); ss += __shfl_xor(ss, 32);
    if (kq == 0) ssp[wave * 16 + r] = ss;
    __syncthreads();
    if (kq == 0 && (wave & 1) == 0 && (!dry || ss == -1.f)) ssq[(size_t)row * 16 + tn] = ss + ssp[(wave + 1) * 16 + r];
  }
  __syncthreads();
}

struct TrDesc { const float* src; const float* gvec; bf16_t* dst; int ldsrc, k0, n0, lddst, drow0, hperm; };
DI TrDesc tr_decode(int tile, const Params& p, unsigned char* ws) {
  constexpr int PER_L = 1408 + 256 * 3 + 1536 + 768 + 32;
  const int l = tile / PER_L; int r = tile % PER_L;
  TrDesc d;
  if (r < 1408) {
    const int kt = r / 88, ntl = r % 88, n0 = ntl * 64;
    const bool qk = (n0 >= 2048 && n0 < 3328);
    d.src = p.in[8] + (size_t)l * DM * DIN; d.ldsrc = DIN; d.k0 = kt * 64; d.n0 = n0; d.gvec = p.in[7] + l * DM; d.dst = (bf16_t*)(ws + WS_WIN + l * SZ_WIN); d.lddst = DM;
    d.drow0 = qk ? (n0 & ~255) : n0; d.hperm = qk ? ((n0 & 255) >> 6) : -1;
    return d; }
  r -= 1408;
  if (r < 768) {
    const int which = r >> 8, rr = r & 255, kt = rr >> 4, ntl = rr & 15;
    d.src = (which == 0 ? p.in[20] : (which == 1 ? p.in[21] : p.in[22])) + (size_t)l * DM * DM;
    d.dst = which < 2 ? (bf16_t*)(ws + WS_WBR + (size_t)(2 * l + which) * SZ_WSQ) : (bf16_t*)(ws + WS_WOUT + l * SZ_WSQ);
    d.ldsrc = DM; d.k0 = kt * 64; d.n0 = ntl * 64; d.gvec = nullptr; d.lddst = DM; d.drow0 = ntl * 64; d.hperm = -1;
    return d; }
  r -= 768;
  if (r < 1536) {
    const int kt = r / 96, ntl = r % 96;
    d.src = p.in[24] + (size_t)l * DM * 2 * DFF; d.ldsrc = 2 * DFF; d.k0 = kt * 64; d.n0 = ntl * 64; d.gvec = p.in[23] + l * DM; d.dst = (bf16_t*)(ws + WS_WUP + l * SZ_WUP); d.lddst = DM;
    d.drow0 = (((ntl * 64) % DFF) >> 7) * 256 + ((ntl * 64) >= DFF ? 128 : 0) + ((ntl * 64) & 64); d.hperm = -1;
    return d; }
  r -= 1536;
  if (r < 768) {
    const int kt = r >> 4, ntl = r & 15;
    d.src = p.in[27] + (size_t)l * DFF * DM; d.ldsrc = DM; d.k0 = kt * 64; d.n0 = ntl * 64; d.gvec = nullptr; d.dst = (bf16_t*)(ws + WS_WDN + l * SZ_WDN); d.lddst = DFF; d.drow0 = ntl * 64; d.hperm = -1;
    return d; }
  r -= 768;
  {
    const int which = r >> 4, nb = r & 15;
    d.src = (which ? p.in[14] : p.in[12]) + (size_t)l * 65536 + nb * 4096;
    d.dst = (bf16_t*)(ws + (which ? WS_WI : WS_WA) + l * SZ_WBD) + nb * 4096;
    d.ldsrc = 64; d.k0 = 0; d.n0 = 0; d.gvec = nullptr; d.lddst = 64; d.drow0 = 0; d.hperm = -1;
    return d; }
}

DI int tr_tile_id(const int mode, const int L, const int idx) {
  if (mode == 0) return L * 4512 + idx;
  if (mode == 1) return L * 4512 + (idx < 2304 ? 1408 + idx : 4480 + (idx - 2304));
  return idx < 768 ? L * 4512 + 3712 + idx : (L + 1) * 4512 + (idx - 768);
}
DI void tr_range(const int tid, LAS unsigned char* lds, const Params& p, unsigned char* ws, const int mode, const int L, const int first_idx, const int count, const int stride) {
  LAS float* tl = (LAS float*)lds;
  const int kk = tid >> 3, n8 = (tid & 7) * 8;
#define TR_LOAD(D, A, B, GS) do { const float* sp_ = (D).src + (size_t)((D).k0 + kk) * (D).ldsrc + (D).n0 + n8; A = *(const f32x4*)sp_; B = *(const f32x4*)(sp_ + 4); GS = (D).gvec ? (D).gvec[(D).k0 + kk] : 1.0f; } while (0)
  f32x4 ca = {0.f, 0.f, 0.f, 0.f}, cb = {0.f, 0.f, 0.f, 0.f}; float cg = 1.f;
  TrDesc d = tr_decode(tr_tile_id(mode, L, first_idx), p, ws);
  if (count > 0) TR_LOAD(d, ca, cb, cg);
  for (int j = 0; j < count; ++j) {
    f32x4 na = {0.f, 0.f, 0.f, 0.f}, nb = {0.f, 0.f, 0.f, 0.f}; float ng = 1.f;
    const bool has = j + 1 < count;
    TrDesc dn = tr_decode(tr_tile_id(mode, L, first_idx + (has ? j + 1 : j) * stride), p, ws);
    if (has) TR_LOAD(dn, na, nb, ng);
    { LAS float* tp = tl + kk * 65 + n8;
      tp[0] = ca[0] * cg; tp[1] = ca[1] * cg; tp[2] = ca[2] * cg; tp[3] = ca[3] * cg; tp[4] = cb[0] * cg; tp[5] = cb[1] * cg; tp[6] = cb[2] * cg; tp[7] = cb[3] * cg; }
    __syncthreads();
    { const int nn = tid >> 3, k8 = (tid & 7) * 8;
      float w[8];
#pragma unroll
      for (int i = 0; i < 8; ++i) w[i] = tl[(k8 + i) * 65 + nn];
      const int dr = d.hperm >= 0 ? (128 * (nn >> 5) + 32 * d.hperm + (nn & 31)) : nn;
      *(u32x4*)(d.dst + (size_t)(d.drow0 + dr) * d.lddst + d.k0 + k8) = pack8(w); }
    __syncthreads();
    d = dn; ca = na; cb = nb; cg = ng;
  }
#undef TR_LOAD
}

DI void phase_prep(const int tid_in, const int bx, const int G, LAS unsigned char* lds, const Params& p, unsigned char* ws, float* out) {
  int tid = tid_in; asm volatile("" : "+v"(tid));
  { const int cnt = bx < 1408 ? (1408 - bx + G - 1) / G : 0; tr_range(tid, lds, p, ws, 0, 0, bx, cnt, G); }
  const int wave = tid >> 6, lane = tid & 63;
  float* X = out; bf16_t* XB = (bf16_t*)(ws + WS_XB); float* ssq = (float*)(ws + WS_SSQ);
  for (int row = bx * 8 + wave; row < T_ALL; row += G * 8) {
    const float* src = row < T_P ? p.in[0] + (size_t)row * DM : p.in[1] + (size_t)(row - T_P) * DM;
    float ss = 0.f;
#pragma unroll
    for (int i = 0; i < 2; ++i) {
      const int col = i * 512 + lane * 8;
      const f32x4 a = *(const f32x4*)(src + col), b = *(const f32x4*)(src + col + 4);
      float w[8] = {a[0], a[1], a[2], a[3], b[0], b[1], b[2], b[3]};
#pragma unroll
      for (int j = 0; j < 8; ++j) ss += w[j] * w[j];
      *(u32x4*)(XB + (size_t)row * DM + col) = pack8(w);
    }
#pragma unroll
    for (int o = 32; o >= 1; o >>= 1) ss += __shfl_xor(ss, o);
    if (lane < 16) ssq[(size_t)row * 16 + lane] = lane == 0 ? ss : 0.f;
  }
}

DI void lru_item(const int tid, LAS unsigned char* lds, const Params& p, unsigned char* ws, float* out, int l, int seq, int cb, bool dry) {
  const int wave = tid >> 6, lane = tid & 63;
  LAS float* XCF = (LAS float*)(lds);
  LAS float* AS = (LAS float*)(lds + 32768);
  LAS float* BS = (LAS float*)(lds + 65536);
  LAS bf16_t* XCB = (LAS bf16_t*)(lds + 98304);
  LAS bf16_t* WA = (LAS bf16_t*)(lds + 116736);
  LAS bf16_t* WI = (LAS bf16_t*)(lds + 125952);
  LAS float* SEGA = (LAS float*)(lds + 135168);
  LAS float* SEGB = (LAS float*)(lds + 137216);
  LAS float* HC = (LAS float*)(lds + 139264);
  LAS float* WC = (LAS float*)(lds + 139776);

  const bool isp = seq < 16; const int b = isp ? seq : seq - 16;
  const int row0 = isp ? seq * 2048 : T_P + b * 32;
  const int nchunks = isp ? 16 : 1, nrows = isp ? 128 : 32;
  const bf16_t* U = (const bf16_t*)(ws + WS_U); bf16_t* GY = (bf16_t*)(ws + WS_GY);
  const int c0 = cb * 64;
  __syncthreads();
  { const bf16_t* wa = (const bf16_t*)(ws + WS_WA + l * SZ_WBD) + cb * 4096; const bf16_t* wi = (const bf16_t*)(ws + WS_WI + l * SZ_WBD) + cb * 4096;
    const int n = tid >> 3, k8 = (tid & 7) * 8;
    *(LAS u32x4*)(WA + n * 72 + k8) = *(const u32x4*)(wa + n * 64 + k8);
    *(LAS u32x4*)(WI + n * 72 + k8) = *(const u32x4*)(wi + n * 64 + k8);
    if (tid < 320) { const int j = tid >> 6, c = tid & 63; WC[tid] = j < 4 ? p.in[10][(size_t)(l * 4 + j) * 1024 + c0 + c] : p.in[11][l * 1024 + c0 + c]; }
    if (tid < 64) HC[tid] = isp ? 0.f : p.in[3][(size_t)(l * 32 + b) * 1024 + c0 + tid]; }
  LAS float* GC = (LAS float*)(lds + 141056);
  if (tid < 64) { const int col = l * 1024 + c0 + tid; GC[tid] = p.in[13][col]; GC[64 + tid] = p.in[15][col]; GC[128 + tid] = -8.0f * log1pf(expf(-p.in[16][col])); }
  __syncthreads();

  u32x4 up[2][4];
#define LRU_ISSUE_U(T0) do { _Pragma("unroll") for (int pass = 0; pass < 2; ++pass) { const int row_ = pass * 64 + (tid >> 3); if (row_ < nrows) { \
      _Pragma("unroll") for (int j = 0; j < 4; ++j) { const int tt_ = (T0) + row_ - 3 + j; up[pass][j] = *(const u32x4*)(U + (size_t)(row0 + (tt_ < 0 ? 0 : tt_)) * 1024 + c0 + (tid & 7) * 8); } } } } while (0)
#pragma unroll
  for (int pass = 0; pass < 2; ++pass)
#pragma unroll
    for (int j = 0; j < 4; ++j) up[pass][j] = (u32x4){0u, 0u, 0u, 0u};
  LRU_ISSUE_U(0);
  for (int ch = 0; ch < nchunks; ++ch) {
    const int t0 = ch * 128;
    const int sc = tid & 63, seg = tid >> 6;
    const bool act = seg * 16 < nrows;
#pragma unroll
    for (int pass = 0; pass < 2; ++pass) {
      const int row = pass * 64 + (tid >> 3), cg = (tid & 7) * 8;
      if (row < nrows) {
        float xc[8];
#pragma unroll
        for (int i = 0; i < 8; ++i) xc[i] = WC[256 + cg + i];
#pragma unroll
        for (int j = 0; j < 4; ++j) {
          const int tt = t0 + row - 3 + j;
          float xe[8];
          const u32x4 a = up[pass][j];
          xe[0] = bflo(a.x); xe[1] = bfhi(a.x); xe[2] = bflo(a.y); xe[3] = bfhi(a.y); xe[4] = bflo(a.z); xe[5] = bfhi(a.z); xe[6] = bflo(a.w); xe[7] = bfhi(a.w);
          if (tt < 0) {
            if (!isp) {
              const float* sp_ = p.in[2] + ((size_t)(l * 32 + b) * 3 + (tt + 3)) * 1024 + c0 + cg;
#pragma unroll
              for (int i = 0; i < 8; ++i) xe[i] = sp_[i];
            } else {
#pragma unroll
              for (int i = 0; i < 8; ++i) xe[i] = 0.f;
            }
          }
#pragma unroll
          for (int i = 0; i < 8; ++i) xc[i] += WC[j * 64 + cg + i] * xe[i];
        }
        *(LAS f32x4*)(XCF + row * 64 + cg) = (f32x4){xc[0], xc[1], xc[2], xc[3]}; *(LAS f32x4*)(XCF + row * 64 + cg + 4) = (f32x4){xc[4], xc[5], xc[6], xc[7]};
        *(LAS u32x4*)(XCB + row * 72 + cg) = pack8(xc);
      }
    }
    if (ch + 1 < nchunks) LRU_ISSUE_U(t0 + 128);
    unsigned short gyr[16];
#pragma unroll
    for (int i = 0; i < 16; ++i) gyr[i] = 0;
    if (act) {
#pragma unroll
      for (int i = 0; i < 16; ++i) gyr[i] = GY[(size_t)(row0 + t0 + seg * 16 + i) * 1024 + c0 + sc];
    }
    __syncthreads();
    if (wave * 16 < nrows) {
      const int ar = wave * 16 + (lane & 15), kq = 8 * (lane >> 4);
      bf16x8 af[2];
#pragma unroll
      for (int ks = 0; ks < 2; ++ks) af[ks] = *(const LAS bf16x8*)(XCB + ar * 72 + 32 * ks + kq);
#pragma unroll
      for (int nt = 0; nt < 4; ++nt) {
        f32x4 accr = {0.f, 0.f, 0.f, 0.f}, acci = {0.f, 0.f, 0.f, 0.f};
#pragma unroll
        for (int ks = 0; ks < 2; ++ks) {
          const bf16x8 bA = *(const LAS bf16x8*)(WA + (16 * nt + (lane & 15)) * 72 + 32 * ks + kq);
          const bf16x8 bI = *(const LAS bf16x8*)(WI + (16 * nt + (lane & 15)) * 72 + 32 * ks + kq);
          accr = __builtin_amdgcn_mfma_f32_16x16x32_bf16(af[ks], bA, accr, 0, 0, 0);
          acci = __builtin_amdgcn_mfma_f32_16x16x32_bf16(af[ks], bI, acci, 0, 0, 0);
        }
#pragma unroll
        for (int j = 0; j < 4; ++j) {
          const int row = wave * 16 + 4 * (lane >> 4) + j, col = 16 * nt + (lane & 15);
          const float r = sigmoidf_(accr[j] + GC[col]), ig = sigmoidf_(acci[j] + GC[64 + col]);
          const float la = GC[128 + col] * r;
          const float a = __builtin_amdgcn_exp2f(la * LOG2E);
          const float x2 = 2.0f * la;
          const float ser = -x2 * (1.0f + x2 * (0.5f + x2 * (0.16666667f + x2 * (0.041666668f + x2 * (0.008333334f + x2 * 0.0013888889f)))));
          const float om = x2 > -0.25f ? ser : 1.0f - a * a;
          AS[row * 64 + col] = a; BS[row * 64 + col] = sqrtf(om) * ig * XCF[row * 64 + col];
        }
      }
    }
    __syncthreads();
    if (act) {
      float A = 1.f, B = 0.f;
#pragma unroll
      for (int i = 0; i < 16; ++i) { const float a = AS[(seg * 16 + i) * 64 + sc], bb = BS[(seg * 16 + i) * 64 + sc]; B = a * B + bb; A *= a; }
      SEGA[seg * 64 + sc] = A; SEGB[seg * 64 + sc] = B;
    }
    __syncthreads();
    if (act) {
      float h = HC[(ch & 1) * 64 + sc];
      { float sa[7], sb[7];
#pragma unroll
        for (int s2 = 0; s2 < 7; ++s2) { sa[s2] = SEGA[s2 * 64 + sc]; sb[s2] = SEGB[s2 * 64 + sc]; }
#pragma unroll
        for (int s2 = 0; s2 < 7; ++s2) if (s2 < seg) h = sa[s2] * h + sb[s2]; }
#pragma unroll
      for (int i = 0; i < 16; ++i) {
        const int r = seg * 16 + i;
        h = AS[r * 64 + sc] * h + BS[r * 64 + sc];
        if (!dry || h == -12345.f) GY[(size_t)(row0 + t0 + r) * 1024 + c0 + sc] = (bf16_t)(pk2(h * bf2f(gyr[i]), 0.f) & 0xffffu);
      }
      if ((seg + 1) * 16 == nrows) {
        HC[((ch + 1) & 1) * 64 + sc] = h;
        if (ch == nchunks - 1 && !dry) out[(isp ? OUT_PLH + (size_t)(l * 16 + b) * 1024 : OUT_SLH + (size_t)(l * 32 + b) * 1024) + c0 + sc] = h;
      }
    }
    __syncthreads();
  }
#undef LRU_ISSUE_U
}

DI void attn_items(const int tid, const int bx, const int G, LAS unsigned char* lds, const Params& p, unsigned char* ws, float* out, int l, bool dry) {
  const int wave = tid >> 6, lane = tid & 63, r = lane & 31, h = lane >> 5;
  LAS bf16_t* KS = (LAS bf16_t*)lds;
  LAS bf16_t* VT = (LAS bf16_t*)(lds + 27648);
  const bf16_t* Kb = (const bf16_t*)(ws + WS_K); const bf16_t* Vb = (const bf16_t*)(ws + WS_V); bf16_t* Q = (bf16_t*)(ws + WS_Q);
  u32x4 kw[3], vw[3]; bf16x8 qf[4];
#pragma unroll
  for (int i = 0; i < 3; ++i) { kw[i] = (u32x4){0u, 0u, 0u, 0u}; vw[i] = (u32x4){0u, 0u, 0u, 0u}; }
#pragma unroll
  for (int s = 0; s < 4; ++s) qf[s] = (bf16x8){0, 0, 0, 0, 0, 0, 0, 0};
#define ATT_LOAD(ID) do { const int id_ = (ID); const bool isp_ = id_ < 2048; const int kvh_ = id_ & 3, b_ = isp_ ? (id_ >> 7) : ((id_ - 2048) >> 2), chunk_ = isp_ ? ((id_ >> 2) & 31) : 0; \
    _Pragma("unroll") for (int i = 0; i < 3; ++i) { const int pc = tid + 512 * i, kk = pc >> 3, d0 = (pc & 7) * 8; \
      kw[i] = (u32x4){0u, 0u, 0u, 0u}; vw[i] = (u32x4){0u, 0u, 0u, 0u}; \
      if (isp_) { const int t = (chunk_ - 2) * 64 + kk; \
        if (t >= 0) { const size_t ro = (size_t)(b_ * 2048 + t) * 256 + kvh_ * 64 + d0; kw[i] = *(const u32x4*)(Kb + ro); vw[i] = *(const u32x4*)(Vb + ro); } \
      } else if (kk < 128) { const size_t co = (((size_t)(l * 32 + b_) * 128 + kk) * 4 + kvh_) * 64 + d0; \
        const f32x4 k0 = *(const f32x4*)(p.in[4] + co), k1 = *(const f32x4*)(p.in[4] + co + 4), v0 = *(const f32x4*)(p.in[5] + co), v1 = *(const f32x4*)(p.in[5] + co + 4); \
        kw[i] = (u32x4){pk2(k0[0], k0[1]), pk2(k0[2], k0[3]), pk2(k1[0], k1[1]), pk2(k1[2], k1[3])}; \
        vw[i] = (u32x4){pk2(v0[0], v0[1]), pk2(v0[2], v0[3]), pk2(v1[0], v1[1]), pk2(v1[2], v1[3])}; \
      } else if (kk < 160) { const size_t ro = (size_t)(T_P + b_ * 32 + (kk - 128)) * 256 + kvh_ * 64 + d0; kw[i] = *(const u32x4*)(Kb + ro); vw[i] = *(const u32x4*)(Vb + ro); } } \
    if (isp_ || wave < 4) { const int g_ = isp_ ? (wave >> 1) : wave; \
      const int qrow_ = isp_ ? (b_ * 2048 + chunk_ * 64 + (wave & 1) * 32 + r) : (T_P + b_ * 32 + r); \
      const bf16_t* qp_ = Q + (size_t)qrow_ * 1024 + (kvh_ * 4 + g_) * 64; \
      _Pragma("unroll") for (int s = 0; s < 4; ++s) qf[s] = *(const bf16x8*)(qp_ + 16 * s + 8 * h); } } while (0)
  int id = bx;
  if (id < 2176) ATT_LOAD(id);
  for (; id < 2176; id += G) {
    const bool isp = id < 2048; const int kvh = id & 3, b = isp ? (id >> 7) : ((id - 2048) >> 2), chunk = isp ? ((id >> 2) & 31) : 0;
    __syncthreads();
#pragma unroll
    for (int i = 0; i < 3; ++i) { const int pc = tid + 512 * i, kk = pc >> 3, d0 = (pc & 7) * 8;
      *(LAS u32x4*)(KS + kk * 72 + d0) = kw[i];
      VT[(d0 + 0) * 200 + kk] = (bf16_t)(vw[i].x & 0xffffu); VT[(d0 + 1) * 200 + kk] = (bf16_t)(vw[i].x >> 16);
      VT[(d0 + 2) * 200 + kk] = (bf16_t)(vw[i].y & 0xffffu); VT[(d0 + 3) * 200 + kk] = (bf16_t)(vw[i].y >> 16);
      VT[(d0 + 4) * 200 + kk] = (bf16_t)(vw[i].z & 0xffffu); VT[(d0 + 5) * 200 + kk] = (bf16_t)(vw[i].z >> 16);
      VT[(d0 + 6) * 200 + kk] = (bf16_t)(vw[i].w & 0xffffu); VT[(d0 + 7) * 200 + kk] = (bf16_t)(vw[i].w >> 16); }
    bf16x8 qc[4];
#pragma unroll
    for (int s = 0; s < 4; ++s) qc[s] = qf[s];
    __syncthreads();
    if (id + G < 2176) ATT_LOAD(id + G);
    const bool active = isp || wave < 4;
    if (active) {
      const int g = isp ? (wave >> 1) : wave, head = kvh * 4 + g;
      const int qrow = isp ? (b * 2048 + chunk * 64 + (wave & 1) * 32 + r) : (T_P + b * 32 + r);
      const int kb_lo = isp ? (chunk >= 2 ? 0 : 2 * (2 - chunk)) : 0, kb_hi = isp ? 6 : 5;
      bf16_t* qp = Q + (size_t)qrow * 1024 + head * 64;
      f32x16 st[6];
#pragma unroll
      for (int kb = 0; kb < 6; ++kb) {
#pragma unroll
        for (int i = 0; i < 16; ++i) st[kb][i] = 0.f;
#pragma unroll
        for (int s = 0; s < 4; ++s) {
          const bf16x8 kf = *(const LAS bf16x8*)(KS + (32 * kb + r) * 72 + 16 * s + 8 * h);
          st[kb] = __builtin_amdgcn_mfma_f32_32x32x16_bf16(kf, qc[s], st[kb], 0, 0, 0);
        }
      }
      const float sinkv = p.in[19][l * 16 + head] * LOG2E;
      const float sscale = 0.125f * LOG2E;
      float mx = sinkv;
#pragma unroll
      for (int kb = 0; kb < 6; ++kb) { const bool valid = kb >= kb_lo && kb < kb_hi;
#pragma unroll
        for (int i = 0; i < 16; ++i) { const float tv = valid ? st[kb][i] * sscale : -1e30f; st[kb][i] = tv; mx = fmaxf(mx, tv); } }
      mx = fmaxf(mx, __shfl_xor(mx, 32));
      float sum = 0.f;
#pragma unroll
      for (int kb = 0; kb < 6; ++kb)
#pragma unroll
        for (int i = 0; i < 16; ++i) { const float pv = __builtin_amdgcn_exp2f(st[kb][i] - mx); st[kb][i] = pv; sum += pv; }
      sum += __shfl_xor(sum, 32);
      sum += __builtin_amdgcn_exp2f(sinkv - mx);
      const float inv = 1.0f / sum;
      f32x16 ot[2];
#pragma unroll
      for (int db = 0; db < 2; ++db)
#pragma unroll
        for (int i = 0; i < 16; ++i) ot[db][i] = 0.f;
#pragma unroll
      for (int kb = 0; kb < 6; ++kb)
#pragma unroll
        for (int s = 0; s < 2; ++s) {
          u32x4 pw; pw.x = pk2(st[kb][8 * s + 0], st[kb][8 * s + 1]); pw.y = pk2(st[kb][8 * s + 2], st[kb][8 * s + 3]); pw.z = pk2(st[kb][8 * s + 4], st[kb][8 * s + 5]); pw.w = pk2(st[kb][8 * s + 6], st[kb][8 * s + 7]);
          const bf16x8 pf = __builtin_bit_cast(bf16x8, pw);
#pragma unroll
          for (int db = 0; db < 2; ++db) {
            const LAS bf16_t* vp = VT + (32 * db + r) * 200 + 32 * kb + 16 * s + 4 * h;
            const u32x2 lo = *(const LAS u32x2*)vp, hi = *(const LAS u32x2*)(vp + 8);
            const u32x4 vv = {lo.x, lo.y, hi.x, hi.y};
            ot[db] = __builtin_amdgcn_mfma_f32_32x32x16_bf16(__builtin_bit_cast(bf16x8, vv), pf, ot[db], 0, 0, 0);
          }
        }
#pragma unroll
      for (int db = 0; db < 2; ++db)
#pragma unroll
        for (int gg = 0; gg < 4; ++gg) {
          u32x2 w; w.x = pk2(ot[db][4 * gg + 0] * inv, ot[db][4 * gg + 1] * inv); w.y = pk2(ot[db][4 * gg + 2] * inv, ot[db][4 * gg + 3] * inv);
          if (!dry || inv == -12345.f) *(u32x2*)(qp + 32 * db + 8 * gg + 4 * h) = w;
        }
    }
  }
#undef ATT_LOAD
}

DI void phase_mixers(const int tid_in, const int bx, const int G, LAS unsigned char* lds, const Params& p, unsigned char* ws, float* out, int l, bool dry) {
  int tid = tid_in; asm volatile("" : "+v"(tid));
  if (!dry || !(REP_MASK & 512)) for (int it = bx; it < 768; it += G) lru_item(tid, lds, p, ws, out, l, it >> 4, it & 15, dry);
  if (!dry || !(REP_MASK & 256)) attn_items(tid, bx, G, lds, p, ws, out, l, dry);
  __syncthreads();
}

DI void phase_ffnfix(const int tid_in, const int bx, const int G, const Params& p, unsigned char* ws, int l, bool dry) {
  int tid = tid_in; asm volatile("" : "+v"(tid));
  bf16_t* ACT = (bf16_t*)(ws + WS_UP); const float* H = (const float*)(ws + WS_H); const float* G0 = (const float*)(ws + WS_G0); const float* U0 = (const float*)(ws + WS_U0);
  const int gt = bx * 512 + tid, nthr = (G * 512 / 384) * 384;
  if (gt >= nthr) return;
  const int c8 = (gt % 384) * 8, d0 = gt / 384, dstep = nthr / 384;
  f32x4 wv[4][2];
#pragma unroll
  for (int j = 0; j < 3; ++j) { wv[j][0] = *(const f32x4*)(p.in[25] + (size_t)(l * 3 + j) * 3072 + c8); wv[j][1] = *(const f32x4*)(p.in[25] + (size_t)(l * 3 + j) * 3072 + c8 + 4); }
  wv[3][0] = *(const f32x4*)(p.in[26] + l * 3072 + c8); wv[3][1] = *(const f32x4*)(p.in[26] + l * 3072 + c8 + 4);
  f32x4 gv[4][2], uv[4][2], p1v[4][2], p2v[4][2]; bool z1[4], z2[4]; int rows[4];
#pragma unroll
  for (int k4 = 0; k4 < 4; ++k4) {
    int d = d0 + k4 * dstep; const bool valid = d < 1088; if (!valid) d = 0;
    const int k = d & 1; const bool isp = d < 1024;
    const int row = isp ? (d >> 1) * 64 + k : T_P + ((d - 1024) >> 1) * 32 + k;
    const int t = isp ? (row & 2047) : ((row - T_P) & 31);
    rows[k4] = valid ? row : -1;
    const size_t so = ((size_t)(row >> 5) * 2 + k) * 3072 + c8;
    const float* st = p.in[6] + ((size_t)(l * 32 + (isp ? 0 : ((row - T_P) >> 5))) * 2) * 3072 + c8;
    const float* hp = H + ((size_t)(isp && t >= 64 ? (row >> 6) - 1 : 0) * 2) * 3072 + c8;
    const float *s1, *s2; z1[k4] = false; z2[k4] = false;
    if (k == 0) { if (t == 0) { s1 = st + 3072; s2 = st; z1[k4] = z2[k4] = isp; } else { s1 = hp + 3072; s2 = hp; } }
    else { s1 = G0 + so - 3072; if (t == 1) { s2 = st + 3072; z2[k4] = isp; } else s2 = hp + 3072; }
    gv[k4][0] = *(const f32x4*)(G0 + so); gv[k4][1] = *(const f32x4*)(G0 + so + 4); uv[k4][0] = *(const f32x4*)(U0 + so); uv[k4][1] = *(const f32x4*)(U0 + so + 4);
    p1v[k4][0] = *(const f32x4*)s1; p1v[k4][1] = *(const f32x4*)(s1 + 4); p2v[k4][0] = *(const f32x4*)s2; p2v[k4][1] = *(const f32x4*)(s2 + 4);
  }
#pragma unroll
  for (int k4 = 0; k4 < 4; ++k4) {
    float o[8];
#pragma unroll
    for (int q = 0; q < 2; ++q)
#pragma unroll
      for (int i = 0; i < 4; ++i) {
        const float a1 = z1[k4] ? 0.f : p1v[k4][q][i], a2 = z2[k4] ? 0.f : p2v[k4][q][i];
        o[4 * q + i] = gelu_tanh(wv[3][q][i] + wv[0][q][i] * a2 + wv[1][q][i] * a1 + wv[2][q][i] * gv[k4][q][i]) * uv[k4][q][i];
      }
    if (rows[k4] >= 0 && (!dry || o[0] == -12345.f)) *(u32x4*)(ACT + (size_t)rows[k4] * 3072 + c8) = pack8(o);
  }
}

#define XB_TMO      128
#define XB_XCNT(j)  (256  + 64 * (j))
#define XB_XSUB(j)  (1280 + 64 * (j))
#define XB_XGEN(j)  (2304 + 64 * (j))
#define XB_TOP      3328
#define XB_TOPGEN   3392
#define XCD_BAR_WORDS 3456
#define XB_SPIN_CAP (1u << 18)
DI unsigned xb_ld(unsigned* p) { return __hip_atomic_load(p, __ATOMIC_RELAXED, __HIP_MEMORY_SCOPE_AGENT); }
DI unsigned xb_add(unsigned* p, unsigned v) { return __hip_atomic_fetch_add(p, v, __ATOMIC_RELAXED, __HIP_MEMORY_SCOPE_AGENT); }
DI unsigned xb_xcc_id() { return (unsigned)__builtin_amdgcn_s_getreg((3 << 11) | 20) & 0xFu; }
#define XB_SPIN(cond, bar) do { unsigned _sp = 0; while (cond) { __builtin_amdgcn_s_sleep(1); \
    if ((++_sp & 255u) == 0u) { if (xb_ld(&(bar)[XB_TMO])) break; if (_sp > XB_SPIN_CAP) { atomicAdd(&(bar)[XB_TMO], 1u); break; } } } } while (0)
DI void xcd_barrier_complete(unsigned* bar, unsigned x, unsigned G, unsigned& nloc, unsigned& nx) {
  unsigned sum, cnt, mine, sp = 0u;
  for (;;) {
    sum = 0u; cnt = 0u; mine = 0u;
#pragma unroll
    for (unsigned j = 0; j < 16; ++j) { const unsigned c = xb_ld(&bar[XB_XCNT(j)]); sum += c; cnt += (c > 0u) ? 1u : 0u; mine = (j == x) ? c : mine; }
    if (sum == G) break;
    __builtin_amdgcn_s_sleep(1);
    if ((++sp & 255u) == 0u) { if (xb_ld(&bar[XB_TMO])) break; if (sp > XB_SPIN_CAP) { atomicAdd(&bar[XB_TMO], 1u); break; } }
  }
  nloc = mine > 0u ? mine : 1u; nx = cnt > 0u ? cnt : 1u;
}
DI void xcd_barrier(const int tid, unsigned* bar, volatile LAS unsigned* st, const unsigned G) {
  asm volatile("s_waitcnt vmcnt(0)" ::: "memory");
  __syncthreads();
  if (tid == 0) {
    const unsigned x = xb_xcc_id();
    __builtin_amdgcn_s_waitcnt(0);
    unsigned nloc = st[0], nx = st[1];
    if (nloc == 0u) { xcd_barrier_complete(bar, x, G, nloc, nx); st[0] = nloc; st[1] = nx; }
    const unsigned old = xb_add(&bar[XB_XSUB(x)], 1u);
    const unsigned gen = old / nloc;
    if (old + 1u == (gen + 1u) * nloc) {
      __builtin_amdgcn_fence(__ATOMIC_RELEASE, "agent");
      asm volatile("s_waitcnt vmcnt(0)" ::: "memory");
      const unsigned og = xb_add(&bar[XB_TOP], 1u);
      const unsigned tg = og / nx;
      if (og + 1u == (tg + 1u) * nx) xb_add(&bar[XB_TOPGEN], 1u);
      else XB_SPIN(xb_ld(&bar[XB_TOPGEN]) == tg, bar);
      __builtin_amdgcn_fence(__ATOMIC_ACQUIRE, "agent");
      xb_add(&bar[XB_XGEN(x)], 1u);
      asm volatile("s_waitcnt vmcnt(0)" ::: "memory");
    } else {
      XB_SPIN(xb_ld(&bar[XB_XGEN(x)]) == gen, bar);
      __builtin_amdgcn_fence(__ATOMIC_ACQUIRE, "agent");
      asm volatile("s_waitcnt vmcnt(0)" ::: "memory");
    }
  }
  __syncthreads();
}

constexpr int N_PHASES = 1 + 7 * 4;
constexpr int LDS_BYTES = 147456;

__global__ void __launch_bounds__(512, 2) mk_fwd(Params p0) {
  extern __shared__ __attribute__((aligned(16))) unsigned char lds_raw[];
  LAS unsigned char* lds = (LAS unsigned char*)lds_raw;
  cg::grid_group grid = cg::this_grid();
  volatile LAS unsigned* bst = (volatile LAS unsigned*)(lds + LDS_BYTES - 16);
  if (threadIdx.x == 0) { bst[0] = 0u; bst[1] = 0u; (void)xb_add((unsigned*)(p0.ws + WS_BAR) + XB_XCNT(xb_xcc_id()), 1u); }
  __syncthreads();
  const int wave_s = __builtin_amdgcn_readfirstlane((int)threadIdx.x >> 6);
  for (int ph = p0.ph_lo; ph < p0.ph_hi; ++ph) {
   const int reps = ((REP_MASK >> (ph == 0 ? 7 : (ph - 1) % 7)) & 1) ? 2 : 1;
   for (int rep = 0; rep < reps; ++rep) {
    const bool dry = rep + 1 < reps;
    __builtin_amdgcn_s_waitcnt(0);
    const Params& p = p0;
    int lane_; asm volatile("v_mbcnt_lo_u32_b32 %0, -1, 0\n\tv_mbcnt_hi_u32_b32 %0, -1, %0" : "=v"(lane_));
    int tid = wave_s * 64 + lane_, bx = blockIdx.x, G = gridDim.x;
    unsigned char* ws = p0.ws; float* out = p0.out; asm volatile("" : "+v"(tid), "+s"(bx), "+s"(G));
    float* ssq = (float*)(ws + WS_SSQ); bf16_t* XB = (bf16_t*)(ws + WS_XB);
    if (ph == 0) phase_prep(tid, bx, G, lds, p, ws, out);
    else {
      const int l = (ph - 1) / 7, s = (ph - 1) % 7;
      if (s == 0) {
        pg8::Gemm g{XB, XB, (const bf16_t*)(ws + WS_WIN + l * SZ_WIN), (const bf16_t*)(ws + WS_WIN + l * SZ_WIN), DM};
        pg8::Order S; S.init(T_ALL, DIN, G, bx, 0);
        Epi1 E{(bf16_t*)(ws + WS_U), (bf16_t*)(ws + WS_GY), (bf16_t*)(ws + WS_Q), (bf16_t*)(ws + WS_K), (bf16_t*)(ws + WS_V), (bf16_t*)(ws + WS_GATES), ssq, p.in[9], p.in[17], p.in[18], out, l};
        pg8::gemm_phase<Epi1>(tid, lds, g, S, E);
        { const int nwg = (T_ALL / 256) * (DIN / 256), busy = nwg - ((nwg - 1) / G) * G;
          if (bx >= busy) { const int k = bx - busy, nid = G - busy, cnt = k < 2336 ? (2336 - k + nid - 1) / nid : 0; tr_range(tid, lds, p, ws, 1, l, k, cnt, nid); } }
      } else if (s == 1) {
        phase_mixers(tid, bx, G, lds, p, ws, out, l, dry);
      } else if (s == 2) {
        pg8::Gemm g{(const bf16_t*)(ws + WS_GY), (const bf16_t*)(ws + WS_Q), (const bf16_t*)(ws + WS_WBR + (size_t)(2 * l) * SZ_WSQ), (const bf16_t*)(ws + WS_WBR + (size_t)(2 * l + 1) * SZ_WSQ), DM};
        for (int t = bx; t < 256; t += G) small_gemm<0>(tid, lds, t, g.A0, g.B0, g.A1, g.B1, DM, (bf16_t*)(ws + WS_MIX), (const bf16_t*)(ws + WS_GATES), nullptr, nullptr, nullptr, dry, false);
        pg8::Order S; S.init(T_P, DM, G, bx, 1);
        EpiBr E{(bf16_t*)(ws + WS_MIX), (const bf16_t*)(ws + WS_GATES)};
        pg8::gemm_phase<EpiBr>(tid, lds, g, S, E);
      } else if (s == 3 || s == 6) {
        const bf16_t* A = s == 3 ? (const bf16_t*)(ws + WS_MIX) : (const bf16_t*)(ws + WS_UP);
        const bf16_t* B = s == 3 ? (const bf16_t*)(ws + WS_WOUT + l * SZ_WSQ) : (const bf16_t*)(ws + WS_WDN + l * SZ_WDN);
        pg8::Gemm g{A, A, B, B, s == 3 ? DM : DFF};
        for (int t = bx; t < 256; t += G) small_gemm<1>(tid, lds, t, A, B, A, B, s == 3 ? DM : DFF, nullptr, nullptr, out, XB, ssq, dry, l == 3 && s == 6);
        pg8::Order S; S.init(T_P, DM, G, bx, 0);
        EpiRes E{out, XB, ssq, dry, l == 3 && s == 6};
        pg8::gemm_phase<EpiRes>(tid, lds, g, S, E);
      } else if (s == 4) {
        pg8::Gemm g{XB, XB, (const bf16_t*)(ws + WS_WUP + l * SZ_WUP), (const bf16_t*)(ws + WS_WUP + l * SZ_WUP), DM};
        pg8::Order S; S.init(T_ALL, 2 * DFF, G, bx, 0);
        EpiUp E{(bf16_t*)(ws + WS_UP), (float*)(ws + WS_H), (float*)(ws + WS_G0), (float*)(ws + WS_U0), ssq, p.in[25], p.in[26], out, l};
        pg8::gemm_phase<EpiUp>(tid, lds, g, S, E);
        { const int nwg = (T_ALL / 256) * (2 * DFF / 256), busy = nwg - ((nwg - 1) / G) * G, ntile = l < 3 ? 2176 : 768;
          if (bx >= busy) { const int k = bx - busy, nid = G - busy, cnt = k < ntile ? (ntile - k + nid - 1) / nid : 0; tr_range(tid, lds, p, ws, 2, l, k, cnt, nid); } }
      } else {
        phase_ffnfix(tid, bx, G, p, ws, l, dry);
      }
    }
    if (dry) xcd_barrier(tid, (unsigned*)(ws + WS_BAR), bst, (unsigned)G);
   }
   if (ph + 1 < p0.ph_hi) {
     if (ph == 0 && (gridDim.x & 7u) != 0u) grid.sync();
     else { int t2 = wave_s * 64; { int l2; asm volatile("v_mbcnt_lo_u32_b32 %0, -1, 0\n\tv_mbcnt_hi_u32_b32 %0, -1, %0" : "=v"(l2)); t2 += l2; }
       xcd_barrier(t2, (unsigned*)(p0.ws + WS_BAR), bst, gridDim.x); }
   }
  }
}

extern "C" void kernel_launch(void* const* d_in, const int* in_sizes, int n_in, void* d_out, int out_size, void* d_ws, size_t ws_size, hipStream_t stream) {
  static int grid = 0;
  if (grid == 0) {
    if (n_in != 28 || ws_size < WS_END) { fprintf(stderr, "kernel_launch: need 28 inputs and %zu bytes of workspace, got %d / %zu\n", (size_t)WS_END, n_in, ws_size); grid = -1; return; }
    int dev = 0, cus = 0, per_cu = 0;
    hipGetDevice(&dev); hipDeviceGetAttribute(&cus, hipDeviceAttributeMultiprocessorCount, dev);
    if (hipFuncSetAttribute((const void*)mk_fwd, hipFuncAttributeMaxDynamicSharedMemorySize, LDS_BYTES) != hipSuccess) { fprintf(stderr, "kernel_launch: hipFuncSetAttribute failed\n"); grid = -1; return; }
    hipOccupancyMaxActiveBlocksPerMultiprocessor(&per_cu, (const void*)mk_fwd, 512, LDS_BYTES);
    (void)hipGetLastError();
    if (per_cu < 1) per_cu = 1;
    grid = cus * per_cu;
    if (grid > 256) grid = 256;
  }
  if (grid < 0) return;
  Params p{};
  for (int i = 0; i < 28; ++i) p.in[i] = (const float*)d_in[i];
  p.out = (float*)d_out; p.ws = (unsigned char*)d_ws;
#if MK_ONE_LAUNCH
  hipMemsetAsync((char*)d_ws + WS_BAR, 0, 16384, stream);
  p.ph_lo = 0; p.ph_hi = N_PHASES;
  void* args[] = {&p};
  hipError_t e = hipLaunchCooperativeKernel((const void*)mk_fwd, dim3(grid), dim3(512), args, LDS_BYTES, stream);
  if (e != hipSuccess) fprintf(stderr, "cooperative launch failed: %s (grid %d)\n", hipGetErrorString(e), grid);
#else
  for (int ph = 0; ph < N_PHASES; ++ph) {
    p.ph_lo = ph; p.ph_hi = ph + 1;
    hipLaunchKernelGGL(mk_fwd, dim3(grid), dim3(512), LDS_BYTES, stream, p);
  }
#endif
}
```

```cpp
#include <hip/hip_runtime.h>
#include <hip/hip_cooperative_groups.h>
#include <cstdio>
namespace cg = cooperative_groups;

#ifndef MK_ONE_LAUNCH
#define MK_ONE_LAUNCH 1
#endif

#ifndef STAGGER
#define STAGGER 0
#endif
#ifndef PG8_SP2
#define PG8_SP2 1
#endif
#ifndef REP_MASK
#define REP_MASK 0
#endif

#define LAS __attribute__((address_space(3)))
#define DI __device__ __forceinline__
typedef unsigned short bf16_t;
typedef short bf16x8 __attribute__((ext_vector_type(8)));
typedef float f32x4 __attribute__((ext_vector_type(4)));
typedef float f32x16 __attribute__((ext_vector_type(16)));
typedef float f32x2 __attribute__((ext_vector_type(2)));
typedef __bf16 bf2_t __attribute__((ext_vector_type(2)));
typedef unsigned u32x4 __attribute__((ext_vector_type(4)));
typedef unsigned u32x2 __attribute__((ext_vector_type(2)));

constexpr int T_P = 32768, T_S = 1024, T_ALL = T_P + T_S;
constexpr int DM = 1024, DIN = 5632, DFF = 3072;
constexpr float EPS = 1e-6f;
constexpr float LOG2E = 1.4426950408889634f;

constexpr size_t OUT_PLC = 34603008, OUT_PLH = 34799616, OUT_PK = 34865152, OUT_PV = 36962304, OUT_PFC = 39059456,
                 OUT_SLC = 39452672, OUT_SLH = 39845888, OUT_SK = 39976960, OUT_SV = 41025536, OUT_SFC = 42074112;

constexpr size_t SZ_WIN = (size_t)DIN * DM * 2, SZ_WSQ = (size_t)DM * DM * 2, SZ_WUP = (size_t)2 * DFF * DM * 2, SZ_WDN = (size_t)DM * DFF * 2, SZ_WBD = 16 * 64 * 64 * 2;
constexpr size_t WS_WIN = 0;
constexpr size_t WS_WBR = WS_WIN + 4 * SZ_WIN;
constexpr size_t WS_WOUT = WS_WBR + 8 * SZ_WSQ;
constexpr size_t WS_WUP = WS_WOUT + 4 * SZ_WSQ;
constexpr size_t WS_WDN = WS_WUP + 4 * SZ_WUP;
constexpr size_t WS_WA = WS_WDN + 4 * SZ_WDN;
constexpr size_t WS_WI = WS_WA + 4 * SZ_WBD;
constexpr size_t WS_XB = WS_WI + 4 * SZ_WBD;
constexpr size_t SLOT = (size_t)T_ALL * DM * 2;
constexpr size_t WS_SSQ = WS_XB + SLOT;
constexpr size_t WS_ST = WS_SSQ + (size_t)T_ALL * 16 * 4;
constexpr size_t WS_U = WS_ST, WS_GY = WS_ST + SLOT, WS_Q = WS_ST + 2 * SLOT, WS_GATES = WS_ST + 3 * SLOT, WS_K = WS_ST + 5 * SLOT, WS_V = WS_K + (size_t)T_ALL * 256 * 2;
constexpr size_t WS_MIX = WS_U;
constexpr size_t WS_GP = WS_ST, WS_UP = WS_ST + 3 * SLOT;
constexpr size_t WS_H = WS_ST, WS_G0 = WS_ST + (16u << 20), WS_U0 = WS_ST + (48u << 20);
constexpr size_t WS_BAR = WS_ST + 6 * SLOT;
constexpr size_t WS_END = WS_BAR + 16384;

struct Params {
  const float* in[28];
  float* out;
  unsigned char* ws;
  int ph_lo, ph_hi;
};

DI unsigned pk2(float lo, float hi) { f32x2 v = {lo, hi}; bf2_t r = __builtin_convertvector(v, bf2_t); return __builtin_bit_cast(unsigned, r); }
DI float bf2f(unsigned short h) { return __uint_as_float(((unsigned)h) << 16); }
DI float bflo(unsigned w) { return __uint_as_float(w << 16); }
DI float bfhi(unsigned w) { return __uint_as_float(w & 0xffff0000u); }
DI float sigmoidf_(float x) { return __builtin_amdgcn_rcpf(1.0f + __builtin_amdgcn_exp2f(-x * LOG2E)); }
DI float gelu_tanh(float x) {
  const float u = x * (1.0f + 0.044715f * x * x) * (1.5957691216057308f * LOG2E);
  return x * __builtin_amdgcn_rcpf(1.0f + __builtin_amdgcn_exp2f(-u));
}
DI u32x4 pack8(const float* v) { u32x4 w; w.x = pk2(v[0], v[1]); w.y = pk2(v[2], v[3]); w.z = pk2(v[4], v[5]); w.w = pk2(v[6], v[7]); return w; }

namespace pg8 {
constexpr int BM = 256, BK = 64, HALF = 128, HTB = HALF * BK * 2, STAGE_BYTES = 8 * HTB, NXCD = 8, WGM = 8;
DI int lds_byte(int r, int c) { const int st = (r >> 4) * 2 + (c >> 5), rr = r & 15, cc = c & 31, ob = rr * 64 + cc * 2; return st * 1024 + (ob ^ (((ob >> 9) & 1) << 5)); }
DI void stage_rc(int b, int& R, int& C) { const int st = b / 1024, sb = b % 1024, swz = sb ^ (((sb >> 9) & 1) << 5); R = (st >> 1) * 16 + swz / 64; C = (st & 1) * 32 + (swz % 64) / 2; }
DI int perm32(int rho) { const int n = rho >> 4, i = rho & 15; return 8 * (i >> 2) + 4 * n + (i & 3); }

struct Unit { int pm, pn, z; };
struct Gemm { const bf16_t *A0, *A1, *B0, *B1; int K; };

struct Order {
  int nM, nN, nwg, G, c, pair;
  DI void init(int M, int N, int G_, int c_, int pair_) { nM = M / BM; nN = N / BM; nwg = nM * nN; G = G_; c = c_; pair = pair_; }
  DI bool next(int i, Unit& u) const {
    const int ii = pair ? (i >> 1) : i;
    const long L = (long)ii * G + c; if (L >= nwg) return false;
    int wgid = (int)L; { const int q = nwg / NXCD, r = nwg % NXCD, xcd = wgid % NXCD, off = wgid / NXCD; wgid = (xcd < r ? xcd * (q + 1) : r * (q + 1) + (xcd - r) * q) + off; }
    const int nig = WGM * nN, gid = wgid / nig, fm = gid * WGM, gsz = (nM - fm) < WGM ? (nM - fm) : WGM;
    u.pm = fm + ((wgid % nig) % gsz); u.pn = (wgid % nig) / gsz; u.z = pair ? (i & 1) : 0; return true;
  }
};

template <class Epi>
DI void gemm_phase(const int tid_in, LAS unsigned char* lds, const Gemm g, const Order& S, const Epi& E) {
  int tid = tid_in; asm volatile("" : "+v"(tid));
  const int wid = __builtin_amdgcn_readfirstlane(tid >> 6), lane = tid & 63, wr = wid >> 2, wc = wid & 3, fr = lane & 15, fq = lane >> 4;
  const int K = g.K, nt = K / BK;
  unsigned voffA[2], voffB[2];
#pragma unroll
  for (int i = 0; i < 2; ++i) { int R, C; stage_rc(tid * 16 + i * 8192, R, C); const int Rb = (R & ~31) + perm32(R & 31);
    voffA[i] = (unsigned)(R * K + C) * 2u; voffB[i] = (unsigned)(Rb * K + C) * 2u; }
  const size_t kstep = (size_t)(BK * 2);
  const size_t hstep = (size_t)HALF * K * 2;
  const size_t tstep = 2 * hstep;
  const unsigned ldsw = (unsigned)wid * 1024u;
  const int aoff = lds_byte(wr * 64 + fr, fq * 8), boff = lds_byte(wc * 32 + fr, fq * 8);
#define PG8_SA(b, h) (((b) * 2 + (h)) * HTB)
#define PG8_SB(b, h) ((4 + (b) * 2 + (h)) * HTB)
#define PG8_STAGE(bufoff, gbase, voff) do { _Pragma("unroll") for (int _i = 0; _i < 2; ++_i) \
    asm volatile("s_mov_b32 m0, %2\n\ts_nop 0\n\tglobal_load_lds_dwordx4 %0, %1" :: "v"((voff)[_i]), "s"((const char*)(gbase)), "s"((unsigned)(size_t)(lds + (bufoff) + ldsw + _i * 8192)) : "memory", "m0"); } while (0)
#define PG8_LDA(dst, b, h) do { _Pragma("unroll") for (int m = 0; m < 4; ++m) _Pragma("unroll") for (int k = 0; k < 2; ++k) dst[m][k] = *(const LAS bf16x8*)(lds + PG8_SA(b, h) + aoff + m * 2048 + k * 1024); } while (0)
#define PG8_LDB(dst, b, h) do { _Pragma("unroll") for (int n = 0; n < 2; ++n) _Pragma("unroll") for (int k = 0; k < 2; ++k) dst[n][k] = *(const LAS bf16x8*)(lds + PG8_SB(b, h) + boff + n * 2048 + k * 1024); } while (0)
#define PG8_MMA(ai, bj, At, Bt) do { __builtin_amdgcn_s_setprio(1); _Pragma("unroll") for (int m = 0; m < 4; ++m) _Pragma("unroll") for (int n = 0; n < 2; ++n) _Pragma("unroll") for (int k = 0; k < 2; ++k) \
    acc[ai][bj][m][n] = __builtin_amdgcn_mfma_f32_16x16x32_bf16(Bt[n][k], At[m][k], acc[ai][bj][m][n], 0, 0, 0); __builtin_amdgcn_s_setprio(0); } while (0)
#define PG8_WAIT_V(n) asm volatile("s_waitcnt vmcnt(" #n ")" ::: "memory")
#define PG8_WAIT_L(n) asm volatile("s_waitcnt lgkmcnt(" #n ")" ::: "memory")
#define PG8_BAR __builtin_amdgcn_s_barrier()
#define PG8_SCHED __builtin_amdgcn_sched_barrier(0)
  Unit cur, nxt; int ui = 0;
  if (!S.next(0, cur)) return;
  if constexpr (Epi::HAS_RS) {
    LAS float* rsl = (LAS float*)(lds + STAGE_BYTES);
    LAS int* pml = (LAS int*)(lds + STAGE_BYTES + 14 * 1024);
    { Unit u2;
#pragma unroll 1
      for (int i = 0; i < 14; ++i) { const bool ok = S.next(i, u2); if (tid == 0) pml[i] = ok ? u2.pm : -1; } }
    __syncthreads();
#pragma unroll 1
    for (int i0 = 0; i0 < 14; i0 += 7) {
      f32x4 pa[7], pb[7]; int pmv[7];
#pragma unroll
      for (int j = 0; j < 7; ++j) { pmv[j] = pml[i0 + j]; pa[j] = (f32x4){0.f, 0.f, 0.f, 0.f}; pb[j] = pa[j];
        if (pmv[j] >= 0) { const float* sp = E.ssq + (size_t)(pmv[j] * 256 + (tid >> 1)) * 16 + (tid & 1) * 8; pa[j] = *(const f32x4*)sp; pb[j] = *(const f32x4*)(sp + 4); } }
#pragma unroll
      for (int j = 0; j < 7; ++j) { float s = pa[j].x + pa[j].y + pa[j].z + pa[j].w + pb[j].x + pb[j].y + pb[j].z + pb[j].w; s += __shfl_xor(s, 1);
        if (pmv[j] >= 0 && (tid & 1) == 0) rsl[(i0 + j) * 256 + (tid >> 1)] = rsqrtf(s * (1.0f / 1024.0f) + EPS); }
    }
    __syncthreads();
  }
  f32x4 acc[2][2][4][2];
#pragma unroll
  for (int a = 0; a < 2; ++a)
#pragma unroll
    for (int b = 0; b < 2; ++b)
#pragma unroll
      for (int m = 0; m < 4; ++m)
#pragma unroll
        for (int n = 0; n < 2; ++n) acc[a][b][m][n] = (f32x4){0.f, 0.f, 0.f, 0.f};
  bf16x8 At[4][2], B0[2][2], B1[2][2];
  const char* cA = (const char*)(cur.z ? g.A1 : g.A0) + (size_t)cur.pm * tstep; const char* cB = (const char*)(cur.z ? g.B1 : g.B0) + (size_t)cur.pn * tstep;
#if PG8_SP2
  PG8_STAGE(PG8_SB(0, 0), cB, voffB); PG8_STAGE(PG8_SB(0, 1), cB + hstep, voffB); PG8_STAGE(PG8_SA(0, 0), cA, voffA); PG8_STAGE(PG8_SA(0, 1), cA + hstep, voffA);
  if (wr == 1) PG8_BAR;
  PG8_WAIT_V(2); PG8_BAR;
  PG8_STAGE(PG8_SB(1, 0), cB + kstep, voffB); PG8_STAGE(PG8_SA(1, 0), cA + kstep, voffA); PG8_STAGE(PG8_SB(1, 1), cB + hstep + kstep, voffB);
  PG8_WAIT_V(6); PG8_BAR;
#else
  PG8_STAGE(PG8_SB(0, 0), cB, voffB); PG8_STAGE(PG8_SA(0, 0), cA, voffA); PG8_STAGE(PG8_SB(0, 1), cB + hstep, voffB); PG8_STAGE(PG8_SA(0, 1), cA + hstep, voffA);
  if (wr == 1) PG8_BAR;
  PG8_WAIT_V(4); PG8_BAR;
  PG8_STAGE(PG8_SB(1, 0), cB + kstep, voffB); PG8_STAGE(PG8_SA(1, 0), cA + kstep, voffA); PG8_STAGE(PG8_SB(1, 1), cB + hstep + kstep, voffB);
  PG8_WAIT_V(6); PG8_BAR;
#endif
  for (;;) {
    const bool has_next = S.next(ui + 1, nxt);
    const char* nA = has_next ? (const char*)(nxt.z ? g.A1 : g.A0) + (size_t)nxt.pm * tstep : cA; const char* nB = has_next ? (const char*)(nxt.z ? g.B1 : g.B0) + (size_t)nxt.pn * tstep : cB;
    for (int t = 0; t < nt; t += 2) {
      const bool last = (t == nt - 2);
      const char* a1 = cA + (size_t)(t + 1) * kstep;
      const char* a2 = last ? nA : cA + (size_t)(t + 2) * kstep; const char* b2 = last ? nB : cB + (size_t)(t + 2) * kstep;
      const char* a3 = a2 + kstep; const char* b3 = b2 + kstep;
#if PG8_SP2
      PG8_LDB(B0, 0, 0); PG8_LDB(B1, 0, 1); PG8_SCHED; PG8_LDA(At, 0, 0); PG8_STAGE(PG8_SA(1, 1), a1 + hstep, voffA);
      PG8_WAIT_V(8); PG8_WAIT_L(0); PG8_BAR; PG8_MMA(0, 0, At, B0); PG8_MMA(0, 1, At, B1); PG8_BAR; PG8_SCHED;
      PG8_LDA(At, 0, 1); PG8_STAGE(PG8_SB(0, 0), b2, voffB); PG8_STAGE(PG8_SB(0, 1), b2 + hstep, voffB); PG8_STAGE(PG8_SA(0, 0), a2, voffA);
      PG8_WAIT_V(8); PG8_WAIT_L(0); PG8_BAR; PG8_MMA(1, 0, At, B0); PG8_MMA(1, 1, At, B1); PG8_BAR; PG8_SCHED;
      PG8_LDB(B0, 1, 0); PG8_LDB(B1, 1, 1); PG8_SCHED; PG8_LDA(At, 1, 0); PG8_STAGE(PG8_SA(0, 1), a2 + hstep, voffA);
      PG8_WAIT_V(8); PG8_WAIT_L(0); PG8_BAR; PG8_MMA(0, 0, At, B0); PG8_MMA(0, 1, At, B1); PG8_BAR; PG8_SCHED;
      PG8_LDA(At, 1, 1); PG8_STAGE(PG8_SB(1, 0), b3, voffB); PG8_STAGE(PG8_SB(1, 1), b3 + hstep, voffB); PG8_STAGE(PG8_SA(1, 0), a3, voffA);
      PG8_WAIT_V(8); PG8_WAIT_L(0); PG8_BAR; PG8_MMA(1, 0, At, B0); PG8_MMA(1, 1, At, B1); PG8_BAR; PG8_SCHED;
#else
      PG8_LDB(B0, 0, 0); PG8_SCHED; PG8_LDA(At, 0, 0); PG8_STAGE(PG8_SA(1, 1), a1 + hstep, voffA);
      PG8_WAIT_L(8); PG8_BAR; PG8_WAIT_L(0); PG8_MMA(0, 0, At, B0); PG8_BAR; PG8_SCHED;
      PG8_LDB(B1, 0, 1); PG8_STAGE(PG8_SB(0, 0), b2, voffB);
      PG8_BAR; PG8_WAIT_L(0); PG8_MMA(0, 1, At, B1); PG8_BAR;
      PG8_LDA(At, 0, 1); PG8_STAGE(PG8_SA(0, 0), a2, voffA);
      PG8_BAR; PG8_WAIT_L(0); PG8_MMA(1, 0, At, B0); PG8_BAR; PG8_SCHED;
      PG8_STAGE(PG8_SB(0, 1), b2 + hstep, voffB);
      PG8_WAIT_V(6); PG8_BAR; PG8_MMA(1, 1, At, B1); PG8_BAR;
      PG8_LDB(B0, 1, 0); PG8_SCHED; PG8_LDA(At, 1, 0); PG8_STAGE(PG8_SA(0, 1), a2 + hstep, voffA);
      PG8_WAIT_L(8); PG8_BAR; PG8_WAIT_L(0); PG8_MMA(0, 0, At, B0); PG8_BAR; PG8_SCHED;
      PG8_LDB(B1, 1, 1); PG8_STAGE(PG8_SB(1, 0), b3, voffB);
      PG8_BAR; PG8_WAIT_L(0); PG8_MMA(0, 1, At, B1); PG8_BAR;
      PG8_LDA(At, 1, 1); PG8_STAGE(PG8_SA(1, 0), a3, voffA);
      PG8_BAR; PG8_WAIT_L(0); PG8_MMA(1, 0, At, B0); PG8_BAR; PG8_SCHED;
      PG8_STAGE(PG8_SB(1, 1), b3 + hstep, voffB);
      PG8_WAIT_V(6); PG8_BAR; PG8_MMA(1, 1, At, B1); PG8_BAR;
#endif
    }
    if (wr == 0) PG8_BAR;
    { int fr2 = fr, fq2 = fq; asm volatile("" : "+v"(fr2), "+v"(fq2)); E(acc, cur, wr, wc, fr2, fq2, (const LAS float*)(lds + STAGE_BYTES) + ui * 256); }
    if (!has_next) break;
#pragma unroll
    for (int a = 0; a < 2; ++a)
#pragma unroll
      for (int b = 0; b < 2; ++b)
#pragma unroll
        for (int m = 0; m < 4; ++m)
#pragma unroll
          for (int n = 0; n < 2; ++n) acc[a][b][m][n] = (f32x4){0.f, 0.f, 0.f, 0.f};
    cur = nxt; cA = nA; cB = nB; ++ui;
    if (wr == 1) PG8_BAR;
  }
  PG8_WAIT_V(0);
  PG8_BAR;
#undef PG8_SA
#undef PG8_SB
#undef PG8_STAGE
#undef PG8_LDA
#undef PG8_LDB
#undef PG8_MMA
#undef PG8_WAIT_V
#undef PG8_WAIT_L
#undef PG8_BAR
#undef PG8_SCHED
}
}
using pg8::Unit;
typedef f32x4 AccT[2][2][4][2];

DI float row_rs(const float* ssq, int row, int fq) {
  const f32x4 pp = *(const f32x4*)(ssq + (size_t)row * 16 + 4 * fq);
  float s = pp.x + pp.y + pp.z + pp.w; s += __shfl_xor(s, 16); s += __shfl_xor(s, 32);
  return rsqrtf(s * (1.0f / 1024.0f) + EPS);
}

struct Epi1 {
  static constexpr bool DRAIN = true, HAS_RS = true;
  bf16_t *U, *GY, *Q, *Kb, *Vb, *GATES; const float* ssq; const float *b_gate, *g_q, *g_k; float* out; int l;
  template <int REG> DI void body(const AccT& acc, const Unit& u, int wr, int wc, int fr, int fq, const LAS float* rsl) const {
    const int pn = u.pn;
#pragma unroll
    for (int ai = 0; ai < 2; ++ai) {
      float rsv[4];
#pragma unroll
      for (int m = 0; m < 4; ++m) rsv[m] = rsl[ai * 128 + wr * 64 + m * 16 + fr];
      __builtin_amdgcn_sched_barrier(0);
#pragma unroll
      for (int m = 0; m < 4; ++m) {
        const int row = u.pm * 256 + ai * 128 + wr * 64 + m * 16 + fr;
        const float rs = rsv[m];
        float v[2][8];
#pragma unroll
        for (int bj = 0; bj < 2; ++bj)
#pragma unroll
          for (int n = 0; n < 2; ++n)
#pragma unroll
            for (int j = 0; j < 4; ++j) v[bj][4 * n + j] = acc[ai][bj][m][n][j] * rs;
        const bool isp = row < T_P; const int rp = row - T_P;
        const int b = isp ? (row >> 11) : (rp >> 5), t = isp ? (row & 2047) : (rp & 31);
        if constexpr (REG == 0) {
          int ooff = -1;
          if (isp) { if (t >= 2045) ooff = (int)OUT_PLC + ((l * 16 + b) * 3 + (t - 2045)) * 1024; }
          else { if (t >= 29) ooff = (int)OUT_SLC + ((l * 32 + b) * 3 + (t - 29)) * 1024; }
#pragma unroll
          for (int bj = 0; bj < 2; ++bj) {
            const int col = pn * 256 + bj * 128 + wc * 32 + fq * 8;
            *(u32x4*)(U + (size_t)row * 1024 + col) = pack8(v[bj]);
            if (ooff >= 0) { float* o = out + ooff + col; *(f32x4*)o = (f32x4){v[bj][0], v[bj][1], v[bj][2], v[bj][3]}; *(f32x4*)(o + 4) = (f32x4){v[bj][4], v[bj][5], v[bj][6], v[bj][7]}; }
          }
        } else if constexpr (REG == 1) {
#pragma unroll
          for (int bj = 0; bj < 2; ++bj) {
            const int col = (pn - 4) * 256 + bj * 128 + wc * 32 + fq * 8;
            float w[8];
#pragma unroll
            for (int i = 0; i < 8; ++i) w[i] = gelu_tanh(v[bj][i]);
            *(u32x4*)(GY + (size_t)row * 1024 + col) = pack8(w);
          }
        } else if constexpr (REG == 2 || REG == 3) {
          float ss = 0.f;
#pragma unroll
          for (int bj = 0; bj < 2; ++bj)
#pragma unroll
            for (int i = 0; i < 8; ++i) ss += v[bj][i] * v[bj][i];
          ss += __shfl_xor(ss, 16); ss += __shfl_xor(ss, 32);
          const float sc = rsqrtf(ss * (1.0f / 64.0f) + EPS);
          int ooff = -1;
          if (REG == 3) { if (isp) { if (t >= 1920) ooff = (int)OUT_PK + ((l * 16 + b) * 128 + (t - 1920)) * 256; } else ooff = (int)OUT_SK + (l * 1024 + rp) * 256; }
#pragma unroll
          for (int bj = 0; bj < 2; ++bj) {
            const int d0 = 32 * bj + 8 * fq;
            const float* gg = (REG == 2 ? g_q : g_k) + l * 64;
            const f32x4 c0 = *(const f32x4*)(gg + d0), c1 = *(const f32x4*)(gg + d0 + 4);
            float w[8];
#pragma unroll
            for (int i = 0; i < 4; ++i) { w[i] = v[bj][i] * sc * c0[i]; w[4 + i] = v[bj][4 + i] * sc * c1[i]; }
            if (REG == 2) *(u32x4*)(Q + (size_t)row * 1024 + (pn - 8) * 256 + 64 * wc + d0) = pack8(w);
            else {
              *(u32x4*)(Kb + (size_t)row * 256 + 64 * wc + d0) = pack8(w);
              if (ooff >= 0) { float* o = out + ooff + 64 * wc + d0; *(f32x4*)o = (f32x4){w[0], w[1], w[2], w[3]}; *(f32x4*)(o + 4) = (f32x4){w[4], w[5], w[6], w[7]}; }
            }
          }
        } else if constexpr (REG == 4) {
          int ooff = -1;
          if (isp) { if (t >= 1920) ooff = (int)OUT_PV + ((l * 16 + b) * 128 + (t - 1920)) * 256; } else ooff = (int)OUT_SV + (l * 1024 + rp) * 256;
#pragma unroll
          for (int bj = 0; bj < 2; ++bj) {
            const int col = bj * 128 + wc * 32 + fq * 8;
            *(u32x4*)(Vb + (size_t)row * 256 + col) = pack8(v[bj]);
            if (ooff >= 0) { float* o = out + ooff + col; *(f32x4*)o = (f32x4){v[bj][0], v[bj][1], v[bj][2], v[bj][3]}; *(f32x4*)(o + 4) = (f32x4){v[bj][4], v[bj][5], v[bj][6], v[bj][7]}; }
          }
        } else {
#pragma unroll
          for (int bj = 0; bj < 2; ++bj) {
            const int col = (pn - 14) * 256 + bj * 128 + wc * 32 + fq * 8;
            const f32x4 c0 = *(const f32x4*)(b_gate + l * 2048 + col), c1 = *(const f32x4*)(b_gate + l * 2048 + col + 4);
            float w[8];
#pragma unroll
            for (int i = 0; i < 4; ++i) { w[i] = sigmoidf_(v[bj][i] + c0[i]); w[4 + i] = sigmoidf_(v[bj][4 + i] + c1[i]); }
            *(u32x4*)(GATES + (size_t)row * 2048 + col) = pack8(w);
          }
        }
        if (m & 1) __builtin_amdgcn_sched_barrier(0);
      }
    }
  }
  DI void operator()(const AccT& acc, const Unit& u, int wr, int wc, int fr, int fq, const LAS float* rsl) const {
    const int pn = u.pn;
    if (pn < 4) body<0>(acc, u, wr, wc, fr, fq, rsl);
    else if (pn < 8) body<1>(acc, u, wr, wc, fr, fq, rsl);
    else if (pn < 12) body<2>(acc, u, wr, wc, fr, fq, rsl);
    else if (pn == 12) body<3>(acc, u, wr, wc, fr, fq, rsl);
    else if (pn == 13) body<4>(acc, u, wr, wc, fr, fq, rsl);
    else body<5>(acc, u, wr, wc, fr, fq, rsl);
  }
};

struct EpiBr {
  static constexpr bool DRAIN = false, HAS_RS = false;
  bf16_t* MIX; const bf16_t* GATES;
  DI void operator()(const AccT& acc, const Unit& u, int wr, int wc, int fr, int fq, const LAS float*) const {
    const int z = u.z;
#pragma unroll
    for (int ai = 0; ai < 2; ++ai) {
      u32x4 gw[4][2], pw[4][2];
#pragma unroll
      for (int m = 0; m < 4; ++m)
#pragma unroll
        for (int bj = 0; bj < 2; ++bj) {
          const int row = u.pm * 256 + ai * 128 + wr * 64 + m * 16 + fr, col = u.pn * 256 + bj * 128 + wc * 32 + fq * 8;
          gw[m][bj] = *(const u32x4*)(GATES + (size_t)row * 2048 + z * 1024 + col);
          pw[m][bj] = (u32x4){0u, 0u, 0u, 0u};
          if (z) pw[m][bj] = *(const u32x4*)(MIX + (size_t)row * 1024 + col);
        }
      __builtin_amdgcn_sched_barrier(0);
#pragma unroll
      for (int m = 0; m < 4; ++m) {
#pragma unroll
        for (int bj = 0; bj < 2; ++bj) {
          const int row = u.pm * 256 + ai * 128 + wr * 64 + m * 16 + fr, col = u.pn * 256 + bj * 128 + wc * 32 + fq * 8;
          const u32x4 g4 = gw[m][bj], p4 = pw[m][bj];
          float w[8];
          w[0] = bflo(g4.x) * acc[ai][bj][m][0][0] + bflo(p4.x); w[1] = bfhi(g4.x) * acc[ai][bj][m][0][1] + bfhi(p4.x);
          w[2] = bflo(g4.y) * acc[ai][bj][m][0][2] + bflo(p4.y); w[3] = bfhi(g4.y) * acc[ai][bj][m][0][3] + bfhi(p4.y);
          w[4] = bflo(g4.z) * acc[ai][bj][m][1][0] + bflo(p4.z); w[5] = bfhi(g4.z) * acc[ai][bj][m][1][1] + bfhi(p4.z);
          w[6] = bflo(g4.w) * acc[ai][bj][m][1][2] + bflo(p4.w); w[7] = bfhi(g4.w) * acc[ai][bj][m][1][3] + bfhi(p4.w);
          *(u32x4*)(MIX + (size_t)row * 1024 + col) = pack8(w);
        }
        if (m & 1) __builtin_amdgcn_sched_barrier(0);
      }
    }
  }
};

struct EpiRes {
  static constexpr bool DRAIN = false, HAS_RS = false;
  float* X; bf16_t* XB; float* ssq; bool dry, fin;
  DI void operator()(const AccT& acc, const Unit& u, int wr, int wc, int fr, int fq, const LAS float*) const {
    u32x4 xv[2][4][2];
#pragma unroll
    for (int ai = 0; ai < 2; ++ai)
#pragma unroll
      for (int m = 0; m < 4; ++m)
#pragma unroll
        for (int bj = 0; bj < 2; ++bj)
          xv[ai][m][bj] = *(const u32x4*)(XB + (size_t)(u.pm * 256 + ai * 128 + wr * 64 + m * 16 + fr) * 1024 + u.pn * 256 + bj * 128 + wc * 32 + fq * 8);
    __builtin_amdgcn_sched_barrier(0);
#pragma unroll
    for (int ai = 0; ai < 2; ++ai)
#pragma unroll
      for (int m = 0; m < 4; ++m) {
        const int row = u.pm * 256 + ai * 128 + wr * 64 + m * 16 + fr;
        float ss = 0.f;
#pragma unroll
        for (int bj = 0; bj < 2; ++bj) {
          const int col = u.pn * 256 + bj * 128 + wc * 32 + fq * 8;
          const u32x4 x4 = xv[ai][m][bj];
          float w[8];
          w[0] = bflo(x4.x) + acc[ai][bj][m][0][0]; w[1] = bfhi(x4.x) + acc[ai][bj][m][0][1]; w[2] = bflo(x4.y) + acc[ai][bj][m][0][2]; w[3] = bfhi(x4.y) + acc[ai][bj][m][0][3];
          w[4] = bflo(x4.z) + acc[ai][bj][m][1][0]; w[5] = bfhi(x4.z) + acc[ai][bj][m][1][1]; w[6] = bflo(x4.w) + acc[ai][bj][m][1][2]; w[7] = bfhi(x4.w) + acc[ai][bj][m][1][3];
#pragma unroll
          for (int i = 0; i < 8; ++i) ss += w[i] * w[i];
          if (!dry) {
            if (fin) { float* xp = X + (size_t)row * 1024 + col; *(f32x4*)xp = (f32x4){w[0], w[1], w[2], w[3]}; *(f32x4*)(xp + 4) = (f32x4){w[4], w[5], w[6], w[7]}; }
            else *(u32x4*)(XB + (size_t)row * 1024 + col) = pack8(w);
          }
        }
        ss += __shfl_xor(ss, 16); ss += __shfl_xor(ss, 32);
        if (fq == 0 && (!dry || ss == -1.f)) ssq[(size_t)row * 16 + u.pn * 4 + wc] = ss;
        if (m & 1) __builtin_amdgcn_sched_barrier(0);
      }
  }
};

struct EpiUp {
  static constexpr bool DRAIN = false, HAS_RS = true;
  bf16_t* ACT; float *H, *G0, *U0; const float* ssq; const float *wf, *bfc; float* out; int l;
  DI void operator()(const AccT& acc, const Unit& u, int wr, int wc, int fr, int fq, const LAS float* rsl) const {
    const int pn = u.pn, colb = pn * 128 + wc * 32 + fq * 8;
    const bool isp = u.pm < 128;
    float rsv[2][4];
#pragma unroll
    for (int ai = 0; ai < 2; ++ai)
#pragma unroll
      for (int m = 0; m < 4; ++m) rsv[ai][m] = rsl[ai * 128 + wr * 64 + m * 16 + fr];
    float w0[8], w1[8], w2[8], bb[8];
    { const float* wp = wf + (size_t)l * 3 * 3072 + colb; const float* bp = bfc + l * 3072 + colb;
      const f32x4 a0 = *(const f32x4*)wp, a1 = *(const f32x4*)(wp + 4), b0 = *(const f32x4*)(wp + 3072), b1 = *(const f32x4*)(wp + 3076), c0 = *(const f32x4*)(wp + 6144), c1 = *(const f32x4*)(wp + 6148), d0 = *(const f32x4*)bp, d1 = *(const f32x4*)(bp + 4);
#pragma unroll
      for (int i = 0; i < 4; ++i) { w0[i] = a0[i]; w0[4 + i] = a1[i]; w1[i] = b0[i]; w1[4 + i] = b1[i]; w2[i] = c0[i]; w2[4 + i] = c1[i]; bb[i] = d0[i]; bb[4 + i] = d1[i]; }
#pragma unroll
      for (int i = 0; i < 8; ++i) asm volatile("" : "+v"(w0[i]), "+v"(w1[i]), "+v"(w2[i]), "+v"(bb[i])); }
    __builtin_amdgcn_s_waitcnt(0x0F70);
    __builtin_amdgcn_sched_barrier(0);
    const int lane = fr + 16 * fq, src1 = (lane & 48) | ((lane - 1) & 15), src2 = (lane & 48) | ((lane - 2) & 15);
#pragma unroll
    for (int ai = 0; ai < 2; ++ai) {
      float pA1[8], pA2[8];
#pragma unroll
      for (int i = 0; i < 8; ++i) { pA1[i] = 0.f; pA2[i] = 0.f; }
#pragma unroll
      for (int m = 0; m < 4; ++m) {
        const int row = u.pm * 256 + ai * 128 + wr * 64 + m * 16 + fr;
        const float rs = rsv[ai][m];
        float g[8], up[8], A1[8], A2[8];
#pragma unroll
        for (int i = 0; i < 4; ++i) { g[i] = acc[ai][0][m][0][i] * rs; g[4 + i] = acc[ai][0][m][1][i] * rs; up[i] = acc[ai][1][m][0][i] * rs; up[4 + i] = acc[ai][1][m][1][i] * rs; }
#pragma unroll
        for (int i = 0; i < 8; ++i) {
          A1[i] = __builtin_bit_cast(float, __builtin_amdgcn_update_dpp(0, __builtin_bit_cast(int, g[i]), 0x121, 0xf, 0xf, false));
          A2[i] = __builtin_bit_cast(float, __builtin_amdgcn_update_dpp(0, __builtin_bit_cast(int, g[i]), 0x122, 0xf, 0xf, false)); }
        const bool deferred = fr < 2 && (m == 0 || (!isp && m == 2));
        if (!deferred) {
          float o[8];
#pragma unroll
          for (int i = 0; i < 8; ++i) { const float p1 = fr >= 1 ? A1[i] : pA1[i], p2 = fr >= 2 ? A2[i] : pA2[i]; o[i] = gelu_tanh(bb[i] + w0[i] * p2 + w1[i] * p1 + w2[i] * g[i]) * up[i]; }
          *(u32x4*)(ACT + (size_t)row * 3072 + colb) = pack8(o);
        } else {
          const size_t so = ((size_t)(row >> 5) * 2 + (row & 1)) * 3072 + colb;
          *(f32x4*)(G0 + so) = (f32x4){g[0], g[1], g[2], g[3]}; *(f32x4*)(G0 + so + 4) = (f32x4){g[4], g[5], g[6], g[7]};
          *(f32x4*)(U0 + so) = (f32x4){up[0], up[1], up[2], up[3]}; *(f32x4*)(U0 + so + 4) = (f32x4){up[4], up[5], up[6], up[7]};
        }
        if (fr >= 14 && (m == 3 || (!isp && m == 1))) {
          if (m == 3) { const size_t ho = ((size_t)(row >> 6) * 2 + (fr - 14)) * 3072 + colb;
            *(f32x4*)(H + ho) = (f32x4){g[0], g[1], g[2], g[3]}; *(f32x4*)(H + ho + 4) = (f32x4){g[4], g[5], g[6], g[7]}; }
          int ooff = -1;
          if (isp) { const int t = row & 2047; if (t >= 2046) ooff = (int)OUT_PFC + ((l * 16 + (row >> 11)) * 2 + (t - 2046)) * 3072; }
          else { const int rp = row - T_P, t = rp & 31; if (t >= 30) ooff = (int)OUT_SFC + ((l * 32 + (rp >> 5)) * 2 + (t - 30)) * 3072; }
          if (ooff >= 0) { float* o = out + ooff + colb; *(f32x4*)o = (f32x4){g[0], g[1], g[2], g[3]}; *(f32x4*)(o + 4) = (f32x4){g[4], g[5], g[6], g[7]}; }
        }
#pragma unroll
        for (int i = 0; i < 8; ++i) { pA1[i] = A1[i]; pA2[i] = A2[i]; }
        __builtin_amdgcn_sched_barrier(0);
      }
    }
  }
};

DI void sg_partial(const int tid, LAS float* red, const bf16_t* A, const bf16_t* B, const int K, const int row0, const int col0, f32x4 (&res)[2]) {
  const int wave = tid >> 6, lane = tid & 63, r = lane & 15, kq = lane >> 4;
  const int KW = K >> 3;
  f32x4 acc[4][4];
#pragma unroll
  for (int rb = 0; rb < 4; ++rb)
#pragma unroll
    for (int cb = 0; cb < 4; ++cb) acc[rb][cb] = (f32x4){0.f, 0.f, 0.f, 0.f};
  const bf16_t* ap = A + (size_t)(row0 + r) * K + wave * KW + 8 * kq;
  const bf16_t* bp = B + (size_t)(col0 + r) * K + wave * KW + 8 * kq;
#pragma unroll 1
  for (int k = 0; k < KW; k += 128) {
    bf16x8 af[4][4], bfr[4][4];
#pragma unroll
    for (int s = 0; s < 4; ++s)
#pragma unroll
      for (int q = 0; q < 4; ++q) { af[s][q] = *(const bf16x8*)(ap + (size_t)q * 16 * K + k + 32 * s); bfr[s][q] = *(const bf16x8*)(bp + (size_t)q * 16 * K + k + 32 * s); }
#pragma unroll
    for (int s = 0; s < 4; ++s)
#pragma unroll
      for (int rb = 0; rb < 4; ++rb)
#pragma unroll
        for (int cb = 0; cb < 4; ++cb) acc[rb][cb] = __builtin_amdgcn_mfma_f32_16x16x32_bf16(bfr[s][cb], af[s][rb], acc[rb][cb], 0, 0, 0);
  }
  __syncthreads();
#pragma unroll
  for (int rb = 0; rb < 4; ++rb)
#pragma unroll
    for (int cb = 0; cb < 4; ++cb) *(LAS f32x4*)(red + ((wave * 16 + rb * 4 + cb) * 64 + lane) * 4) = acc[rb][cb];
  __syncthreads();
#pragma unroll
  for (int h = 0; h < 2; ++h) {
    const int blk = (wave >> 1) * 4 + 2 * (wave & 1) + h;
    f32x4 s = *(const LAS f32x4*)(red + ((0 * 16 + blk) * 64 + lane) * 4);
#pragma unroll
    for (int w2 = 1; w2 < 8; ++w2) s += *(const LAS f32x4*)(red + ((w2 * 16 + blk) * 64 + lane) * 4);
    res[h] = s;
  }
}
template <int MODE>
DI void small_gemm(const int tid, LAS unsigned char* lds, const int tile, const bf16_t* A0, const bf16_t* B0, const bf16_t* A1, const bf16_t* B1, const int K,
                   bf16_t* MIX, const bf16_t* GATES, float* X, bf16_t* XB, float* ssq, const bool dry, const bool fin) {
  const int wave = tid >> 6, lane = tid & 63, r = lane & 15, kq = lane >> 4;
  const int tm = tile >> 4, tn = tile & 15, row0 = T_P + tm * 64, col0 = tn * 64;
  LAS float* red = (LAS float*)lds;
  LAS float* ssp = (LAS float*)(lds + 131072);
  const int row = row0 + 16 * (wave >> 1) + r;
  f32x4 c0[2];
  sg_partial(tid, red, A0, B0, K, row0, col0, c0);
  if constexpr (MODE == 0) {
    f32x4 c1[2];
    sg_partial(tid, red, A1, B1, K, row0, col0, c1);
#pragma unroll
    for (int h = 0; h < 2; ++h) {
      const int col = col0 + 16 * (2 * (wave & 1) + h) + 4 * kq;
      const u32x2 g0 = *(const u32x2*)(GATES + (size_t)row * 2048 + col), g1 = *(const u32x2*)(GATES + (size_t)row * 2048 + 1024 + col);
      u32x2 w;
      w.x = pk2(bflo(g0.x) * c0[h][0] + bflo(g1.x) * c1[h][0], bfhi(g0.x) * c0[h][1] + bfhi(g1.x) * c1[h][1]);
      w.y = pk2(bflo(g0.y) * c0[h][2] + bflo(g1.y) * c1[h][2], bfhi(g0.y) * c0[h][3] + bfhi(g1.y) * c1[h][3]);
      *(u32x2*)(MIX + (size_t)row * 1024 + col) = w;
    }
  } else {
    float ss = 0.f;
#pragma unroll
    for (int h = 0; h < 2; ++h) {
      const int col = col0 + 16 * (2 * (wave & 1) + h) + 4 * kq;
      const u32x2 xb2 = *(const u32x2*)(XB + (size_t)row * 1024 + col);
      const f32x4 w = (f32x4){bflo(xb2.x), bfhi(xb2.x), bflo(xb2.y), bfhi(xb2.y)} + c0[h];
      ss += w[0] * w[0] + w[1] * w[1] + w[2] * w[2] + w[3] * w[3];
      if (!dry) { if (fin) *(f32x4*)(X + (size_t)row * 1024 + col) = w; else { u32x2 wb; wb.x = pk2(w[0], w[1]); wb.y = pk2(w[2], w[3]); *(u32x2*)(XB + (size_t)row * 1024 + col) = wb; } }
    }
    ss += __shfl_xor(ss, 16); ss += __shfl_xor(ss, 32);
    if (kq == 0) ssp[wave * 16 + r] = ss;
    __syncthreads();
    if (kq == 0 && (wave & 1) == 0 && (!dry || ss == -1.f)) ssq[(size_t)row * 16 + tn] = ss + ssp[(wave + 1) * 16 + r];
  }
  __syncthreads();
}

struct TrDesc { const float* src; const float* gvec; bf16_t* dst; int ldsrc, k0, n0, lddst, drow0, hperm; };
DI TrDesc tr_decode(int tile, const Params& p, unsigned char* ws) {
  constexpr int PER_L = 1408 + 256 * 3 + 1536 + 768 + 32;
  const int l = tile / PER_L; int r = tile % PER_L;
  TrDesc d;
  if (r < 1408) {
    const int kt = r / 88, ntl = r % 88, n0 = ntl * 64;
    const bool qk = (n0 >= 2048 && n0 < 3328);
    d.src = p.in[8] + (size_t)l * DM * DIN; d.ldsrc = DIN; d.k0 = kt * 64; d.n0 = n0; d.gvec = p.in[7] + l * DM; d.dst = (bf16_t*)(ws + WS_WIN + l * SZ_WIN); d.lddst = DM;
    d.drow0 = qk ? (n0 & ~255) : n0; d.hperm = qk ? ((n0 & 255) >> 6) : -1;
    return d; }
  r -= 1408;
  if (r < 768) {
    const int which = r >> 8, rr = r & 255, kt = rr >> 4, ntl = rr & 15;
    d.src = (which == 0 ? p.in[20] : (which == 1 ? p.in[21] : p.in[22])) + (size_t)l * DM * DM;
    d.dst = which < 2 ? (bf16_t*)(ws + WS_WBR + (size_t)(2 * l + which) * SZ_WSQ) : (bf16_t*)(ws + WS_WOUT + l * SZ_WSQ);
    d.ldsrc = DM; d.k0 = kt * 64; d.n0 = ntl * 64; d.gvec = nullptr; d.lddst = DM; d.drow0 = ntl * 64; d.hperm = -1;
    return d; }
  r -= 768;
  if (r < 1536) {
    const int kt = r / 96, ntl = r % 96;
    d.src = p.in[24] + (size_t)l * DM * 2 * DFF; d.ldsrc = 2 * DFF; d.k0 = kt * 64; d.n0 = ntl * 64; d.gvec = p.in[23] + l * DM; d.dst = (bf16_t*)(ws + WS_WUP + l * SZ_WUP); d.lddst = DM;
    d.drow0 = (((ntl * 64) % DFF) >> 7) * 256 + ((ntl * 64) >= DFF ? 128 : 0) + ((ntl * 64) & 64); d.hperm = -1;
    return d; }
  r -= 1536;
  if (r < 768) {
    const int kt = r >> 4, ntl = r & 15;
    d.src = p.in[27] + (size_t)l * DFF * DM; d.ldsrc = DM; d.k0 = kt * 64; d.n0 = ntl * 64; d.gvec = nullptr; d.dst = (bf16_t*)(ws + WS_WDN + l * SZ_WDN); d.lddst = DFF; d.drow0 = ntl * 64; d.hperm = -1;
    return d; }
  r -= 768;
  {
    const int which = r >> 4, nb = r & 15;
    d.src = (which ? p.in[14] : p.in[12]) + (size_t)l * 65536 + nb * 4096;
    d.dst = (bf16_t*)(ws + (which ? WS_WI : WS_WA) + l * SZ_WBD) + nb * 4096;
    d.ldsrc = 64; d.k0 = 0; d.n0 = 0; d.gvec = nullptr; d.lddst = 64; d.drow0 = 0; d.hperm = -1;
    return d; }
}

DI int tr_tile_id(const int mode, const int L, const int idx) {
  if (mode == 0) return L * 4512 + idx;
  if (mode == 1) return L * 4512 + (idx < 2304 ? 1408 + idx : 4480 + (idx - 2304));
  return idx < 768 ? L * 4512 + 3712 + idx : (L + 1) * 4512 + (idx - 768);
}
DI void tr_range(const int tid, LAS unsigned char* lds, const Params& p, unsigned char* ws, const int mode, const int L, const int first_idx, const int count, const int stride) {
  LAS float* tl = (LAS float*)lds;
  const int kk = tid >> 3, n8 = (tid & 7) * 8;
#define TR_LOAD(D, A, B, GS) do { const float* sp_ = (D).src + (size_t)((D).k0 + kk) * (D).ldsrc + (D).n0 + n8; A = *(const f32x4*)sp_; B = *(const f32x4*)(sp_ + 4); GS = (D).gvec ? (D).gvec[(D).k0 + kk] : 1.0f; } while (0)
  f32x4 ca = {0.f, 0.f, 0.f, 0.f}, cb = {0.f, 0.f, 0.f, 0.f}; float cg = 1.f;
  TrDesc d = tr_decode(tr_tile_id(mode, L, first_idx), p, ws);
  if (count > 0) TR_LOAD(d, ca, cb, cg);
  for (int j = 0; j < count; ++j) {
    f32x4 na = {0.f, 0.f, 0.f, 0.f}, nb = {0.f, 0.f, 0.f, 0.f}; float ng = 1.f;
    const bool has = j + 1 < count;
    TrDesc dn = tr_decode(tr_tile_id(mode, L, first_idx + (has ? j + 1 : j) * stride), p, ws);
    if (has) TR_LOAD(dn, na, nb, ng);
    { LAS float* tp = tl + kk * 65 + n8;
      tp[0] = ca[0] * cg; tp[1] = ca[1] * cg; tp[2] = ca[2] * cg; tp[3] = ca[3] * cg; tp[4] = cb[0] * cg; tp[5] = cb[1] * cg; tp[6] = cb[2] * cg; tp[7] = cb[3] * cg; }
    __syncthreads();
    { const int nn = tid >> 3, k8 = (tid & 7) * 8;
      float w[8];
#pragma unroll
      for (int i = 0; i < 8; ++i) w[i] = tl[(k8 + i) * 65 + nn];
      const int dr = d.hperm >= 0 ? (128 * (nn >> 5) + 32 * d.hperm + (nn & 31)) : nn;
      *(u32x4*)(d.dst + (size_t)(d.drow0 + dr) * d.lddst + d.k0 + k8) = pack8(w); }
    __syncthreads();
    d = dn; ca = na; cb = nb; cg = ng;
  }
#undef TR_LOAD
}

DI void phase_prep(const int tid_in, const int bx, const int G, LAS unsigned char* lds, const Params& p, unsigned char* ws, float* out) {
  int tid = tid_in; asm volatile("" : "+v"(tid));
  { const int cnt = bx < 1408 ? (1408 - bx + G - 1) / G : 0; tr_range(tid, lds, p, ws, 0, 0, bx, cnt, G); }
  const int wave = tid >> 6, lane = tid & 63;
  float* X = out; bf16_t* XB = (bf16_t*)(ws + WS_XB); float* ssq = (float*)(ws + WS_SSQ);
  for (int rowb = bx * 8 + wave; rowb < T_ALL; rowb += 4 * G * 8) {
    f32x4 xa[4][2], xb4[4][2];
#pragma unroll
    for (int k = 0; k < 4; ++k) {
      int row = rowb + k * G * 8; if (row >= T_ALL) row = rowb;
      const float* src = row < T_P ? p.in[0] + (size_t)row * DM : p.in[1] + (size_t)(row - T_P) * DM;
#pragma unroll
      for (int i = 0; i < 2; ++i) { xa[k][i] = *(const f32x4*)(src + i * 512 + lane * 8); xb4[k][i] = *(const f32x4*)(src + i * 512 + lane * 8 + 4); }
    }
#pragma unroll
    for (int k = 0; k < 4; ++k) {
      const int row = rowb + k * G * 8;
      float ss = 0.f;
#pragma unroll
      for (int i = 0; i < 2; ++i) {
        const f32x4 a = xa[k][i], b = xb4[k][i];
        float w[8] = {a[0], a[1], a[2], a[3], b[0], b[1], b[2], b[3]};
#pragma unroll
        for (int j = 0; j < 8; ++j) ss += w[j] * w[j];
        if (row < T_ALL) *(u32x4*)(XB + (size_t)row * DM + i * 512 + lane * 8) = pack8(w);
      }
#pragma unroll
      for (int o = 32; o >= 1; o >>= 1) ss += __shfl_xor(ss, o);
      if (lane < 16 && row < T_ALL) ssq[(size_t)row * 16 + lane] = lane == 0 ? ss : 0.f;
    }
  }
}

DI void lru_item(const int tid, LAS unsigned char* lds, const Params& p, unsigned char* ws, float* out, int l, int seq, int cb, bool dry) {
  const int wave = tid >> 6, lane = tid & 63;
  LAS float* XCF = (LAS float*)(lds);
  LAS float* AS = (LAS float*)(lds + 32768);
  LAS float* BS = (LAS float*)(lds + 65536);
  LAS bf16_t* XCB = (LAS bf16_t*)(lds + 98304);
  LAS bf16_t* WA = (LAS bf16_t*)(lds + 116736);
  LAS bf16_t* WI = (LAS bf16_t*)(lds + 125952);
  LAS float* SEGA = (LAS float*)(lds + 135168);
  LAS float* SEGB = (LAS float*)(lds + 137216);
  LAS float* HC = (LAS float*)(lds + 139264);
  LAS float* WC = (LAS float*)(lds + 139776);

  const bool isp = seq < 16; const int b = isp ? seq : seq - 16;
  const int row0 = isp ? seq * 2048 : T_P + b * 32;
  const int nchunks = isp ? 16 : 1, nrows = isp ? 128 : 32;
  const bf16_t* U = (const bf16_t*)(ws + WS_U); bf16_t* GY = (bf16_t*)(ws + WS_GY);
  const int c0 = cb * 64;
  __syncthreads();
  { const bf16_t* wa = (const bf16_t*)(ws + WS_WA + l * SZ_WBD) + cb * 4096; const bf16_t* wi = (const bf16_t*)(ws + WS_WI + l * SZ_WBD) + cb * 4096;
    const int n = tid >> 3, k8 = (tid & 7) * 8;
    *(LAS u32x4*)(WA + n * 72 + k8) = *(const u32x4*)(wa + n * 64 + k8);
    *(LAS u32x4*)(WI + n * 72 + k8) = *(const u32x4*)(wi + n * 64 + k8);
    if (tid < 320) { const int j = tid >> 6, c = tid & 63; WC[tid] = j < 4 ? p.in[10][(size_t)(l * 4 + j) * 1024 + c0 + c] : p.in[11][l * 1024 + c0 + c]; }
    if (tid < 64) HC[tid] = isp ? 0.f : p.in[3][(size_t)(l * 32 + b) * 1024 + c0 + tid]; }
  LAS float* GC = (LAS float*)(lds + 141056);
  if (tid < 64) { const int col = l * 1024 + c0 + tid; GC[tid] = p.in[13][col]; GC[64 + tid] = p.in[15][col]; GC[128 + tid] = -8.0f * log1pf(expf(-p.in[16][col])); }
  __syncthreads();

  u32x4 up[2][4];
#define LRU_ISSUE_U(T0) do { _Pragma("unroll") for (int pass = 0; pass < 2; ++pass) { const int row_ = pass * 64 + (tid >> 3); if (row_ < nrows) { \
      _Pragma("unroll") for (int j = 0; j < 4; ++j) { const int tt_ = (T0) + row_ - 3 + j; up[pass][j] = *(const u32x4*)(U + (size_t)(row0 + (tt_ < 0 ? 0 : tt_)) * 1024 + c0 + (tid & 7) * 8); } } } } while (0)
#pragma unroll
  for (int pass = 0; pass < 2; ++pass)
#pragma unroll
    for (int j = 0; j < 4; ++j) up[pass][j] = (u32x4){0u, 0u, 0u, 0u};
  LRU_ISSUE_U(0);
  for (int ch = 0; ch < nchunks; ++ch) {
    const int t0 = ch * 128;
    const int sc = tid & 63, seg = tid >> 6;
    const bool act = seg * 16 < nrows;
#pragma unroll
    for (int pass = 0; pass < 2; ++pass) {
      const int row = pass * 64 + (tid >> 3), cg = (tid & 7) * 8;
      if (row < nrows) {
        float xc[8];
#pragma unroll
        for (int i = 0; i < 8; ++i) xc[i] = WC[256 + cg + i];
#pragma unroll
        for (int j = 0; j < 4; ++j) {
          const int tt = t0 + row - 3 + j;
          float xe[8];
          const u32x4 a = up[pass][j];
          xe[0] = bflo(a.x); xe[1] = bfhi(a.x); xe[2] = bflo(a.y); xe[3] = bfhi(a.y); xe[4] = bflo(a.z); xe[5] = bfhi(a.z); xe[6] = bflo(a.w); xe[7] = bfhi(a.w);
          if (tt < 0) {
            if (!isp) {
              const float* sp_ = p.in[2] + ((size_t)(l * 32 + b) * 3 + (tt + 3)) * 1024 + c0 + cg;
#pragma unroll
              for (int i = 0; i < 8; ++i) xe[i] = sp_[i];
            } else {
#pragma unroll
              for (int i = 0; i < 8; ++i) xe[i] = 0.f;
            }
          }
#pragma unroll
          for (int i = 0; i < 8; ++i) xc[i] += WC[j * 64 + cg + i] * xe[i];
        }
        *(LAS f32x4*)(XCF + row * 64 + cg) = (f32x4){xc[0], xc[1], xc[2], xc[3]}; *(LAS f32x4*)(XCF + row * 64 + cg + 4) = (f32x4){xc[4], xc[5], xc[6], xc[7]};
        *(LAS u32x4*)(XCB + row * 72 + cg) = pack8(xc);
      }
    }
    if (ch + 1 < nchunks) LRU_ISSUE_U(t0 + 128);
    unsigned short gyr[16];
#pragma unroll
    for (int i = 0; i < 16; ++i) gyr[i] = 0;
    if (act) {
#pragma unroll
      for (int i = 0; i < 16; ++i) gyr[i] = GY[(size_t)(row0 + t0 + seg * 16 + i) * 1024 + c0 + sc];
    }
    __syncthreads();
    if (wave * 16 < nrows) {
      const int ar = wave * 16 + (lane & 15), kq = 8 * (lane >> 4);
      bf16x8 af[2];
#pragma unroll
      for (int ks = 0; ks < 2; ++ks) af[ks] = *(const LAS bf16x8*)(XCB + ar * 72 + 32 * ks + kq);
#pragma unroll
      for (int nt = 0; nt < 4; ++nt) {
        f32x4 accr = {0.f, 0.f, 0.f, 0.f}, acci = {0.f, 0.f, 0.f, 0.f};
#pragma unroll
        for (int ks = 0; ks < 2; ++ks) {
          const bf16x8 bA = *(const LAS bf16x8*)(WA + (16 * nt + (lane & 15)) * 72 + 32 * ks + kq);
          const bf16x8 bI = *(const LAS bf16x8*)(WI + (16 * nt + (lane & 15)) * 72 + 32 * ks + kq);
          accr = __builtin_amdgcn_mfma_f32_16x16x32_bf16(af[ks], bA, accr, 0, 0, 0);
          acci = __builtin_amdgcn_mfma_f32_16x16x32_bf16(af[ks], bI, acci, 0, 0, 0);
        }
#pragma unroll
        for (int j = 0; j < 4; ++j) {
          const int row = wave * 16 + 4 * (lane >> 4) + j, col = 16 * nt + (lane & 15);
          const float r = sigmoidf_(accr[j] + GC[col]), ig = sigmoidf_(acci[j] + GC[64 + col]);
          const float la = GC[128 + col] * r;
          const float a = __builtin_amdgcn_exp2f(la * LOG2E);
          const float x2 = 2.0f * la;
          const float ser = -x2 * (1.0f + x2 * (0.5f + x2 * (0.16666667f + x2 * (0.041666668f + x2 * (0.008333334f + x2 * 0.0013888889f)))));
          const float om = x2 > -0.25f ? ser : 1.0f - a * a;
          AS[row * 64 + col] = a; BS[row * 64 + col] = sqrtf(om) * ig * XCF[row * 64 + col];
        }
      }
    }
    __syncthreads();
    if (act) {
      float A = 1.f, B = 0.f;
#pragma unroll
      for (int i = 0; i < 16; ++i) { const float a = AS[(seg * 16 + i) * 64 + sc], bb = BS[(seg * 16 + i) * 64 + sc]; B = a * B + bb; A *= a; }
      SEGA[seg * 64 + sc] = A; SEGB[seg * 64 + sc] = B;
    }
    __syncthreads();
    if (act) {
      float h = HC[(ch & 1) * 64 + sc];
      { float sa[7], sb[7];
#pragma unroll
        for (int s2 = 0; s2 < 7; ++s2) { sa[s2] = SEGA[s2 * 64 + sc]; sb[s2] = SEGB[s2 * 64 + sc]; }
#pragma unroll
        for (int s2 = 0; s2 < 7; ++s2) if (s2 < seg) h = sa[s2] * h + sb[s2]; }
#pragma unroll
      for (int i = 0; i < 16; ++i) {
        const int r = seg * 16 + i;
        h = AS[r * 64 + sc] * h + BS[r * 64 + sc];
        if (!dry || h == -12345.f) GY[(size_t)(row0 + t0 + r) * 1024 + c0 + sc] = (bf16_t)(pk2(h * bf2f(gyr[i]), 0.f) & 0xffffu);
      }
      if ((seg + 1) * 16 == nrows) {
        HC[((ch + 1) & 1) * 64 + sc] = h;
        if (ch == nchunks - 1 && !dry) out[(isp ? OUT_PLH + (size_t)(l * 16 + b) * 1024 : OUT_SLH + (size_t)(l * 32 + b) * 1024) + c0 + sc] = h;
      }
    }
    __syncthreads();
  }
#undef LRU_ISSUE_U
}

DI void attn_items(const int tid, const int bx, const int G, LAS unsigned char* lds, const Params& p, unsigned char* ws, float* out, int l, bool dry) {
  const int wave = tid >> 6, lane = tid & 63, r = lane & 31, h = lane >> 5;
  LAS bf16_t* KS = (LAS bf16_t*)lds;
  LAS bf16_t* VT = (LAS bf16_t*)(lds + 27648);
  const bf16_t* Kb = (const bf16_t*)(ws + WS_K); const bf16_t* Vb = (const bf16_t*)(ws + WS_V); bf16_t* Q = (bf16_t*)(ws + WS_Q);
  u32x4 kw[3], vw[3]; bf16x8 qf[4];
#pragma unroll
  for (int i = 0; i < 3; ++i) { kw[i] = (u32x4){0u, 0u, 0u, 0u}; vw[i] = (u32x4){0u, 0u, 0u, 0u}; }
#pragma unroll
  for (int s = 0; s < 4; ++s) qf[s] = (bf16x8){0, 0, 0, 0, 0, 0, 0, 0};
#define ATT_LOAD(ID) do { const int id_ = (ID); const bool isp_ = id_ < 2048; const int kvh_ = id_ & 3, b_ = isp_ ? (id_ >> 7) : ((id_ - 2048) >> 2), chunk_ = isp_ ? ((id_ >> 2) & 31) : 0; \
    _Pragma("unroll") for (int i = 0; i < 3; ++i) { const int pc = tid + 512 * i, kk = pc >> 3, d0 = (pc & 7) * 8; \
      kw[i] = (u32x4){0u, 0u, 0u, 0u}; vw[i] = (u32x4){0u, 0u, 0u, 0u}; \
      if (isp_) { const int t = (chunk_ - 2) * 64 + kk; \
        if (t >= 0) { const size_t ro = (size_t)(b_ * 2048 + t) * 256 + kvh_ * 64 + d0; kw[i] = *(const u32x4*)(Kb + ro); vw[i] = *(const u32x4*)(Vb + ro); } \
      } else if (kk < 128) { const size_t co = (((size_t)(l * 32 + b_) * 128 + kk) * 4 + kvh_) * 64 + d0; \
        const f32x4 k0 = *(const f32x4*)(p.in[4] + co), k1 = *(const f32x4*)(p.in[4] + co + 4), v0 = *(const f32x4*)(p.in[5] + co), v1 = *(const f32x4*)(p.in[5] + co + 4); \
        kw[i] = (u32x4){pk2(k0[0], k0[1]), pk2(k0[2], k0[3]), pk2(k1[0], k1[1]), pk2(k1[2], k1[3])}; \
        vw[i] = (u32x4){pk2(v0[0], v0[1]), pk2(v0[2], v0[3]), pk2(v1[0], v1[1]), pk2(v1[2], v1[3])}; \
      } else if (kk < 160) { const size_t ro = (size_t)(T_P + b_ * 32 + (kk - 128)) * 256 + kvh_ * 64 + d0; kw[i] = *(const u32x4*)(Kb + ro); vw[i] = *(const u32x4*)(Vb + ro); } } \
    if (isp_ || wave < 4) { const int g_ = isp_ ? (wave >> 1) : wave; \
      const int qrow_ = isp_ ? (b_ * 2048 + chunk_ * 64 + (wave & 1) * 32 + r) : (T_P + b_ * 32 + r); \
      const bf16_t* qp_ = Q + (size_t)qrow_ * 1024 + (kvh_ * 4 + g_) * 64; \
      _Pragma("unroll") for (int s = 0; s < 4; ++s) qf[s] = *(const bf16x8*)(qp_ + 16 * s + 8 * h); } } while (0)
  int id = bx;
  if (id < 2176) ATT_LOAD(id);
  for (; id < 2176; id += G) {
    const bool isp = id < 2048; const int kvh = id & 3, b = isp ? (id >> 7) : ((id - 2048) >> 2), chunk = isp ? ((id >> 2) & 31) : 0;
    __syncthreads();
#pragma unroll
    for (int i = 0; i < 3; ++i) { const int pc = tid + 512 * i, kk = pc >> 3, d0 = (pc & 7) * 8;
      *(LAS u32x4*)(KS + kk * 72 + d0) = kw[i];
      VT[(d0 + 0) * 200 + kk] = (bf16_t)(vw[i].x & 0xffffu); VT[(d0 + 1) * 200 + kk] = (bf16_t)(vw[i].x >> 16);
      VT[(d0 + 2) * 200 + kk] = (bf16_t)(vw[i].y & 0xffffu); VT[(d0 + 3) * 200 + kk] = (bf16_t)(vw[i].y >> 16);
      VT[(d0 + 4) * 200 + kk] = (bf16_t)(vw[i].z & 0xffffu); VT[(d0 + 5) * 200 + kk] = (bf16_t)(vw[i].z >> 16);
      VT[(d0 + 6) * 200 + kk] = (bf16_t)(vw[i].w & 0xffffu); VT[(d0 + 7) * 200 + kk] = (bf16_t)(vw[i].w >> 16); }
    bf16x8 qc[4];
#pragma unroll
    for (int s = 0; s < 4; ++s) qc[s] = qf[s];
    __syncthreads();
    if (id + G < 2176) ATT_LOAD(id + G);
    const bool active = isp || wave < 4;
    if (active) {
      const int g = isp ? (wave >> 1) : wave, head = kvh * 4 + g;
      const int qrow = isp ? (b * 2048 + chunk * 64 + (wave & 1) * 32 + r) : (T_P + b * 32 + r);
      const int kb_lo = isp ? (chunk >= 2 ? 0 : 2 * (2 - chunk)) : 0, kb_hi = isp ? 6 : 5;
      bf16_t* qp = Q + (size_t)qrow * 1024 + head * 64;
      f32x16 st[6];
#pragma unroll
      for (int kb = 0; kb < 6; ++kb) {
#pragma unroll
        for (int i = 0; i < 16; ++i) st[kb][i] = 0.f;
#pragma unroll
        for (int s = 0; s < 4; ++s) {
          const bf16x8 kf = *(const LAS bf16x8*)(KS + (32 * kb + r) * 72 + 16 * s + 8 * h);
          st[kb] = __builtin_amdgcn_mfma_f32_32x32x16_bf16(kf, qc[s], st[kb], 0, 0, 0);
        }
      }
      const float sinkv = p.in[19][l * 16 + head] * LOG2E;
      const float sscale = 0.125f * LOG2E;
      float mx = sinkv;
#pragma unroll
      for (int kb = 0; kb < 6; ++kb) { const bool valid = kb >= kb_lo && kb < kb_hi;
#pragma unroll
        for (int i = 0; i < 16; ++i) { const float tv = valid ? st[kb][i] * sscale : -1e30f; st[kb][i] = tv; mx = fmaxf(mx, tv); } }
      mx = fmaxf(mx, __shfl_xor(mx, 32));
      float sum = 0.f;
#pragma unroll
      for (int kb = 0; kb < 6; ++kb)
#pragma unroll
        for (int i = 0; i < 16; ++i) { const float pv = __builtin_amdgcn_exp2f(st[kb][i] - mx); st[kb][i] = pv; sum += pv; }
      sum += __shfl_xor(sum, 32);
      sum += __builtin_amdgcn_exp2f(sinkv - mx);
      const float inv = 1.0f / sum;
      f32x16 ot[2];
#pragma unroll
      for (int db = 0; db < 2; ++db)
#pragma unroll
        for (int i = 0; i < 16; ++i) ot[db][i] = 0.f;
#pragma unroll
      for (int kb = 0; kb < 6; ++kb)
#pragma unroll
        for (int s = 0; s < 2; ++s) {
          u32x4 pw; pw.x = pk2(st[kb][8 * s + 0], st[kb][8 * s + 1]); pw.y = pk2(st[kb][8 * s + 2], st[kb][8 * s + 3]); pw.z = pk2(st[kb][8 * s + 4], st[kb][8 * s + 5]); pw.w = pk2(st[kb][8 * s + 6], st[kb][8 * s + 7]);
          const bf16x8 pf = __builtin_bit_cast(bf16x8, pw);
#pragma unroll
          for (int db = 0; db < 2; ++db) {
            const LAS bf16_t* vp = VT + (32 * db + r) * 200 + 32 * kb + 16 * s + 4 * h;
            const u32x2 lo = *(const LAS u32x2*)vp, hi = *(const LAS u32x2*)(vp + 8);
            const u32x4 vv = {lo.x, lo.y, hi.x, hi.y};
            ot[db] = __builtin_amdgcn_mfma_f32_32x32x16_bf16(__builtin_bit_cast(bf16x8, vv), pf, ot[db], 0, 0, 0);
          }
        }
#pragma unroll
      for (int db = 0; db < 2; ++db)
#pragma unroll
        for (int gg = 0; gg < 4; ++gg) {
          u32x2 w; w.x = pk2(ot[db][4 * gg + 0] * inv, ot[db][4 * gg + 1] * inv); w.y = pk2(ot[db][4 * gg + 2] * inv, ot[db][4 * gg + 3] * inv);
          if (!dry || inv == -12345.f) *(u32x2*)(qp + 32 * db + 8 * gg + 4 * h) = w;
        }
    }
  }
#undef ATT_LOAD
}

DI void phase_mixers(const int tid_in, const int bx, const int G, LAS unsigned char* lds, const Params& p, unsigned char* ws, float* out, int l, bool dry) {
  int tid = tid_in; asm volatile("" : "+v"(tid));
  if (!dry || !(REP_MASK & 512)) for (int it = bx; it < 768; it += G) lru_item(tid, lds, p, ws, out, l, it >> 4, it & 15, dry);
  if (!dry || !(REP_MASK & 256)) attn_items(tid, bx, G, lds, p, ws, out, l, dry);
  __syncthreads();
}

DI void phase_ffnfix(const int tid_in, const int bx, const int G, const Params& p, unsigned char* ws, int l, bool dry) {
  int tid = tid_in; asm volatile("" : "+v"(tid));
  bf16_t* ACT = (bf16_t*)(ws + WS_UP); const float* H = (const float*)(ws + WS_H); const float* G0 = (const float*)(ws + WS_G0); const float* U0 = (const float*)(ws + WS_U0);
  const int gt = bx * 512 + tid, nthr = (G * 512 / 384) * 384;
  if (gt >= nthr) return;
  const int c8 = (gt % 384) * 8, d0 = gt / 384, dstep = nthr / 384;
  f32x4 wv[4][2];
#pragma unroll
  for (int j = 0; j < 3; ++j) { wv[j][0] = *(const f32x4*)(p.in[25] + (size_t)(l * 3 + j) * 3072 + c8); wv[j][1] = *(const f32x4*)(p.in[25] + (size_t)(l * 3 + j) * 3072 + c8 + 4); }
  wv[3][0] = *(const f32x4*)(p.in[26] + l * 3072 + c8); wv[3][1] = *(const f32x4*)(p.in[26] + l * 3072 + c8 + 4);
  f32x4 gv[4][2], uv[4][2], p1v[4][2], p2v[4][2]; bool z1[4], z2[4]; int rows[4];
#pragma unroll
  for (int k4 = 0; k4 < 4; ++k4) {
    int d = d0 + k4 * dstep; const bool valid = d < 1088; if (!valid) d = 0;
    const int k = d & 1; const bool isp = d < 1024;
    const int row = isp ? (d >> 1) * 64 + k : T_P + ((d - 1024) >> 1) * 32 + k;
    const int t = isp ? (row & 2047) : ((row - T_P) & 31);
    rows[k4] = valid ? row : -1;
    const size_t so = ((size_t)(row >> 5) * 2 + k) * 3072 + c8;
    const float* st = p.in[6] + ((size_t)(l * 32 + (isp ? 0 : ((row - T_P) >> 5))) * 2) * 3072 + c8;
    const float* hp = H + ((size_t)(isp && t >= 64 ? (row >> 6) - 1 : 0) * 2) * 3072 + c8;
    const float *s1, *s2; z1[k4] = false; z2[k4] = false;
    if (k == 0) { if (t == 0) { s1 = st + 3072; s2 = st; z1[k4] = z2[k4] = isp; } else { s1 = hp + 3072; s2 = hp; } }
    else { s1 = G0 + so - 3072; if (t == 1) { s2 = st + 3072; z2[k4] = isp; } else s2 = hp + 3072; }
    gv[k4][0] = *(const f32x4*)(G0 + so); gv[k4][1] = *(const f32x4*)(G0 + so + 4); uv[k4][0] = *(const f32x4*)(U0 + so); uv[k4][1] = *(const f32x4*)(U0 + so + 4);
    p1v[k4][0] = *(const f32x4*)s1; p1v[k4][1] = *(const f32x4*)(s1 + 4); p2v[k4][0] = *(const f32x4*)s2; p2v[k4][1] = *(const f32x4*)(s2 + 4);
  }
#pragma unroll
  for (int k4 = 0; k4 < 4; ++k4) {
    float o[8];
#pragma unroll
    for (int q = 0; q < 2; ++q)
#pragma unroll
      for (int i = 0; i < 4; ++i) {
        const float a1 = z1[k4] ? 0.f : p1v[k4][q][i], a2 = z2[k4] ? 0.f : p2v[k4][q][i];
        o[4 * q + i] = gelu_tanh(wv[3][q][i] + wv[0][q][i] * a2 + wv[1][q][i] * a1 + wv[2][q][i] * gv[k4][q][i]) * uv[k4][q][i];
      }
    if (rows[k4] >= 0 && (!dry || o[0] == -12345.f)) *(u32x4*)(ACT + (size_t)rows[k4] * 3072 + c8) = pack8(o);
  }
}

#define XB_TMO      128
#define XB_XCNT(j)  (256  + 64 * (j))
#define XB_XSUB(j)  (1280 + 64 * (j))
#define XB_XGEN(j)  (2304 + 64 * (j))
#define XB_TOP      3328
#define XB_TOPGEN   3392
#define XCD_BAR_WORDS 3456
#define XB_SPIN_CAP (1u << 18)
DI unsigned xb_ld(unsigned* p) { return __hip_atomic_load(p, __ATOMIC_RELAXED, __HIP_MEMORY_SCOPE_AGENT); }
DI unsigned xb_add(unsigned* p, unsigned v) { return __hip_atomic_fetch_add(p, v, __ATOMIC_RELAXED, __HIP_MEMORY_SCOPE_AGENT); }
DI unsigned xb_xcc_id() { return (unsigned)__builtin_amdgcn_s_getreg((3 << 11) | 20) & 0xFu; }
#define XB_SPIN(cond, bar) do { unsigned _sp = 0; while (cond) { __builtin_amdgcn_s_sleep(1); \
    if ((++_sp & 255u) == 0u) { if (xb_ld(&(bar)[XB_TMO])) break; if (_sp > XB_SPIN_CAP) { atomicAdd(&(bar)[XB_TMO], 1u); break; } } } } while (0)
DI void xcd_barrier_complete(unsigned* bar, unsigned x, unsigned G, unsigned& nloc, unsigned& nx) {
  unsigned sum, cnt, mine, sp = 0u;
  for (;;) {
    sum = 0u; cnt = 0u; mine = 0u;
#pragma unroll
    for (unsigned j = 0; j < 16; ++j) { const unsigned c = xb_ld(&bar[XB_XCNT(j)]); sum += c; cnt += (c > 0u) ? 1u : 0u; mine = (j == x) ? c : mine; }
    if (sum == G) break;
    __builtin_amdgcn_s_sleep(1);
    if ((++sp & 255u) == 0u) { if (xb_ld(&bar[XB_TMO])) break; if (sp > XB_SPIN_CAP) { atomicAdd(&bar[XB_TMO], 1u); break; } }
  }
  nloc = mine > 0u ? mine : 1u; nx = cnt > 0u ? cnt : 1u;
}
DI void xcd_barrier(const int tid, unsigned* bar, volatile LAS unsigned* st, const unsigned G) {
  asm volatile("s_waitcnt vmcnt(0)" ::: "memory");
  __syncthreads();
  if (tid == 0) {
    const unsigned x = xb_xcc_id();
    __builtin_amdgcn_s_waitcnt(0);
    unsigned nloc = st[0], nx = st[1];
    if (nloc == 0u) { xcd_barrier_complete(bar, x, G, nloc, nx); st[0] = nloc; st[1] = nx; }
    const unsigned old = xb_add(&bar[XB_XSUB(x)], 1u);
    const unsigned gen = old / nloc;
    if (old + 1u == (gen + 1u) * nloc) {
      __builtin_amdgcn_fence(__ATOMIC_RELEASE, "agent");
      asm volatile("s_waitcnt vmcnt(0)" ::: "memory");
      const unsigned og = xb_add(&bar[XB_TOP], 1u);
      const unsigned tg = og / nx;
      if (og + 1u == (tg + 1u) * nx) xb_add(&bar[XB_TOPGEN], 1u);
      else XB_SPIN(xb_ld(&bar[XB_TOPGEN]) == tg, bar);
      __builtin_amdgcn_fence(__ATOMIC_ACQUIRE, "agent");
      xb_add(&bar[XB_XGEN(x)], 1u);
      asm volatile("s_waitcnt vmcnt(0)" ::: "memory");
    } else {
      XB_SPIN(xb_ld(&bar[XB_XGEN(x)]) == gen, bar);
      __builtin_amdgcn_fence(__ATOMIC_ACQUIRE, "agent");
      asm volatile("s_waitcnt vmcnt(0)" ::: "memory");
    }
  }
  __syncthreads();
}

constexpr int N_PHASES = 1 + 7 * 4;
constexpr int LDS_BYTES = 147456;

__global__ void __launch_bounds__(512, 2) mk_fwd(Params p0) {
  extern __shared__ __attribute__((aligned(16))) unsigned char lds_raw[];
  LAS unsigned char* lds = (LAS unsigned char*)lds_raw;
  cg::grid_group grid = cg::this_grid();
  volatile LAS unsigned* bst = (volatile LAS unsigned*)(lds + LDS_BYTES - 16);
  if (threadIdx.x == 0) { bst[0] = 0u; bst[1] = 0u; (void)xb_add((unsigned*)(p0.ws + WS_BAR) + XB_XCNT(xb_xcc_id()), 1u); }
  __syncthreads();
  const int wave_s = __builtin_amdgcn_readfirstlane((int)threadIdx.x >> 6);
  for (int ph = p0.ph_lo; ph < p0.ph_hi; ++ph) {
   const int reps = ((REP_MASK >> (ph == 0 ? 7 : (ph - 1) % 7)) & 1) ? 2 : 1;
   for (int rep = 0; rep < reps; ++rep) {
    const bool dry = rep + 1 < reps;
    __builtin_amdgcn_s_waitcnt(0);
    const Params& p = p0;
    int lane_; asm volatile("v_mbcnt_lo_u32_b32 %0, -1, 0\n\tv_mbcnt_hi_u32_b32 %0, -1, %0" : "=v"(lane_));
    int tid = wave_s * 64 + lane_, bx = blockIdx.x, G = gridDim.x;
    unsigned char* ws = p0.ws; float* out = p0.out; asm volatile("" : "+v"(tid), "+s"(bx), "+s"(G));
    float* ssq = (float*)(ws + WS_SSQ); bf16_t* XB = (bf16_t*)(ws + WS_XB);
    if (ph == 0) phase_prep(tid, bx, G, lds, p, ws, out);
    else {
      const int l = (ph - 1) / 7, s = (ph - 1) % 7;
      if (s == 0) {
        pg8::Gemm g{XB, XB, (const bf16_t*)(ws + WS_WIN + l * SZ_WIN), (const bf16_t*)(ws + WS_WIN + l * SZ_WIN), DM};
        pg8::Order S; S.init(T_ALL, DIN, G, bx, 0);
        Epi1 E{(bf16_t*)(ws + WS_U), (bf16_t*)(ws + WS_GY), (bf16_t*)(ws + WS_Q), (bf16_t*)(ws + WS_K), (bf16_t*)(ws + WS_V), (bf16_t*)(ws + WS_GATES), ssq, p.in[9], p.in[17], p.in[18], out, l};
        pg8::gemm_phase<Epi1>(tid, lds, g, S, E);
        { const int nwg = (T_ALL / 256) * (DIN / 256), busy = nwg - ((nwg - 1) / G) * G;
          if (bx >= busy) { const int k = bx - busy, nid = G - busy, cnt = k < 2336 ? (2336 - k + nid - 1) / nid : 0; tr_range(tid, lds, p, ws, 1, l, k, cnt, nid); } }
      } else if (s == 1) {
        phase_mixers(tid, bx, G, lds, p, ws, out, l, dry);
      } else if (s == 2) {
        pg8::Gemm g{(const bf16_t*)(ws + WS_GY), (const bf16_t*)(ws + WS_Q), (const bf16_t*)(ws + WS_WBR + (size_t)(2 * l) * SZ_WSQ), (const bf16_t*)(ws + WS_WBR + (size_t)(2 * l + 1) * SZ_WSQ), DM};
        for (int t = bx; t < 256; t += G) small_gemm<0>(tid, lds, t, g.A0, g.B0, g.A1, g.B1, DM, (bf16_t*)(ws + WS_MIX), (const bf16_t*)(ws + WS_GATES), nullptr, nullptr, nullptr, dry, false);
        pg8::Order S; S.init(T_P, DM, G, bx, 1);
        EpiBr E{(bf16_t*)(ws + WS_MIX), (const bf16_t*)(ws + WS_GATES)};
        pg8::gemm_phase<EpiBr>(tid, lds, g, S, E);
      } else if (s == 3 || s == 6) {
        const bf16_t* A = s == 3 ? (const bf16_t*)(ws + WS_MIX) : (const bf16_t*)(ws + WS_UP);
        const bf16_t* B = s == 3 ? (const bf16_t*)(ws + WS_WOUT + l * SZ_WSQ) : (const bf16_t*)(ws + WS_WDN + l * SZ_WDN);
        pg8::Gemm g{A, A, B, B, s == 3 ? DM : DFF};
        for (int t = bx; t < 256; t += G) small_gemm<1>(tid, lds, t, A, B, A, B, s == 3 ? DM : DFF, nullptr, nullptr, out, XB, ssq, dry, l == 3 && s == 6);
        pg8::Order S; S.init(T_P, DM, G, bx, 0);
        EpiRes E{out, XB, ssq, dry, l == 3 && s == 6};
        pg8::gemm_phase<EpiRes>(tid, lds, g, S, E);
      } else if (s == 4) {
        pg8::Gemm g{XB, XB, (const bf16_t*)(ws + WS_WUP + l * SZ_WUP), (const bf16_t*)(ws + WS_WUP + l * SZ_WUP), DM};
        pg8::Order S; S.init(T_ALL, 2 * DFF, G, bx, 0);
        EpiUp E{(bf16_t*)(ws + WS_UP), (float*)(ws + WS_H), (float*)(ws + WS_G0), (float*)(ws + WS_U0), ssq, p.in[25], p.in[26], out, l};
        pg8::gemm_phase<EpiUp>(tid, lds, g, S, E);
        { const int nwg = (T_ALL / 256) * (2 * DFF / 256), busy = nwg - ((nwg - 1) / G) * G, ntile = l < 3 ? 2176 : 768;
          if (bx >= busy) { const int k = bx - busy, nid = G - busy, cnt = k < ntile ? (ntile - k + nid - 1) / nid : 0; tr_range(tid, lds, p, ws, 2, l, k, cnt, nid); } }
      } else {
        phase_ffnfix(tid, bx, G, p, ws, l, dry);
      }
    }
    if (dry) xcd_barrier(tid, (unsigned*)(ws + WS_BAR), bst, (unsigned)G);
   }
   if (ph + 1 < p0.ph_hi) {
     if (ph == 0 && (gridDim.x & 7u) != 0u) grid.sync();
     else { int t2 = wave_s * 64; { int l2; asm volatile("v_mbcnt_lo_u32_b32 %0, -1, 0\n\tv_mbcnt_hi_u32_b32 %0, -1, %0" : "=v"(l2)); t2 += l2; }
       xcd_barrier(t2, (unsigned*)(p0.ws + WS_BAR), bst, gridDim.x); }
   }
  }
}

extern "C" void kernel_launch(void* const* d_in, const int* in_sizes, int n_in, void* d_out, int out_size, void* d_ws, size_t ws_size, hipStream_t stream) {
  static int grid = 0;
  if (grid == 0) {
    if (n_in != 28 || ws_size < WS_END) { fprintf(stderr, "kernel_launch: need 28 inputs and %zu bytes of workspace, got %d / %zu\n", (size_t)WS_END, n_in, ws_size); grid = -1; return; }
    int dev = 0, cus = 0, per_cu = 0;
    hipGetDevice(&dev); hipDeviceGetAttribute(&cus, hipDeviceAttributeMultiprocessorCount, dev);
    if (hipFuncSetAttribute((const void*)mk_fwd, hipFuncAttributeMaxDynamicSharedMemorySize, LDS_BYTES) != hipSuccess) { fprintf(stderr, "kernel_launch: hipFuncSetAttribute failed\n"); grid = -1; return; }
    hipOccupancyMaxActiveBlocksPerMultiprocessor(&per_cu, (const void*)mk_fwd, 512, LDS_BYTES);
    (void)hipGetLastError();
    if (per_cu < 1) per_cu = 1;
    grid = cus * per_cu;
    if (grid > 256) grid = 256;
  }
  if (grid < 0) return;
  Params p{};
  for (int i = 0; i < 28; ++i) p.in[i] = (const float*)d_in[i];
  p.out = (float*)d_out; p.ws = (unsigned char*)d_ws;
#if MK_ONE_LAUNCH
  hipMemsetAsync((char*)d_ws + WS_BAR, 0, 16384, stream);
  p.ph_lo = 0; p.ph_hi = N_PHASES;
  void* args[] = {&p};
  hipError_t e = hipLaunchCooperativeKernel((const void*)mk_fwd, dim3(grid), dim3(512), args, LDS_BYTES, stream);
  if (e != hipSuccess) fprintf(stderr, "cooperative launch failed: %s (grid %d)\n", hipGetErrorString(e), grid);
#else
  for (int ph = 0; ph < N_PHASES; ++ph) {
    p.ph_lo = ph; p.ph_hi = ph + 1;
    hipLaunchKernelGGL(mk_fwd, dim3(grid), dim3(512), LDS_BYTES, stream, p);
  }
#endif
}
```
